# Optimizing an MI355X kernel written in HIP

```python
import math
import jax, jax.numpy as jnp
from jax import lax
import numpy as np

D_MODEL = 4096
BATCH = 1
SEQ = 16384
DEPTH = 2

N_A = DEPTH // 2
N_B = DEPTH - N_A

POOL_WINDOWS = (2, 4, 8, 16)
N_POOL_GROUPS = len(POOL_WINDOWS)
POOL_GROUP_DIM = D_MODEL // N_POOL_GROUPS

QK_NOPE_DIM = 128
QK_ROPE_DIM = 64
V_HEAD_DIM = 128
N_HEADS = D_MODEL // V_HEAD_DIM
QK_HEAD_DIM = QK_NOPE_DIM + QK_ROPE_DIM
Q_LORA_RANK = 1024
KV_LORA_RANK = 512
ROPE_THETA = 10000.0
Q_BLOCK = 128

D_FF = 11008
CONV_WIDTH = 3

EPS = 1e-6

kernel_name = "yoco_pool_mla_convffn_trunk"


def rmsnorm(x, g):
    xf = x.astype(jnp.float32)
    y = xf * lax.rsqrt(jnp.mean(xf * xf, axis=-1, keepdims=True) + EPS)
    return (y * g.astype(jnp.float32)).astype(x.dtype)


def rope_tables(seq_len, dim, dtype):
    inv_freq = ROPE_THETA ** (-jnp.arange(0, dim, 2, dtype=jnp.float32) / dim)
    ang = jnp.arange(seq_len, dtype=jnp.float32)[:, None] * inv_freq[None, :]
    return jnp.cos(ang).astype(dtype), jnp.sin(ang).astype(dtype)


def apply_rope(x, cos, sin):
    x1, x2 = jnp.split(x, 2, axis=-1)
    return jnp.concatenate([x1 * cos - x2 * sin, x2 * cos + x1 * sin], axis=-1)


def multiscale_pool_mixer(xn, w_groups, scale):
    B, S, D = xn.shape
    xg = xn.astype(jnp.float32).reshape(B, S, N_POOL_GROUPS, POOL_GROUP_DIM)
    csum = jnp.concatenate(
        [jnp.zeros((B, 1, N_POOL_GROUPS, POOL_GROUP_DIM), jnp.float32), jnp.cumsum(xg, axis=1)],
        axis=1)
    t = jnp.arange(S)
    outs = []
    for gi, w in enumerate(POOL_WINDOWS):
        c = csum[:, :, gi]
        hi = c[:, 1:]
        lo = jnp.concatenate([jnp.zeros((B, w - 1, POOL_GROUP_DIM), jnp.float32),
                              c[:, :S - w + 1]], axis=1)
        count = jnp.minimum(t + 1, w).astype(jnp.float32)[None, :, None]
        outs.append((hi - lo) / count - xg[:, :, gi])
    pooled = jnp.stack(outs, axis=2).astype(xn.dtype)
    mixed = jnp.einsum('bsgc,gcd->bsgd', pooled, w_groups).reshape(B, S, D)
    return mixed * scale


def conv_ffn(xn, w_in, conv_w, conv_b, w_out):
    S = xn.shape[1]
    u = xn @ w_in
    up = jnp.pad(u, ((0, 0), (CONV_WIDTH - 1, 0), (0, 0)))
    uc = sum(conv_w[k] * up[:, k:k + S] for k in range(CONV_WIDTH)) + conv_b
    gate, val = jnp.split(uc, 2, axis=-1)
    return (jax.nn.silu(gate) * val) @ w_out


def shared_latent_kv(h, kv_norm, w_dkv, kv_lat_norm, w_ukv, cos, sin):
    hn = rmsnorm(h, kv_norm)
    ckv = hn @ w_dkv
    c_kv = rmsnorm(ckv[..., :KV_LORA_RANK], kv_lat_norm)
    k_rope = apply_rope(ckv[..., KV_LORA_RANK:], cos, sin)
    kv = jnp.einsum('bsc,chd->bshd', c_kv, w_ukv)
    return kv[..., :QK_NOPE_DIM], k_rope, kv[..., QK_NOPE_DIM:]


def mla_mixer(xn, w_dq, q_lat_norm, w_uq, w_o, k_nope, k_rope, v, cos, sin):
    B, S, _ = xn.shape
    c_q = rmsnorm(xn @ w_dq, q_lat_norm)
    q = jnp.einsum('bsc,chd->bshd', c_q, w_uq)
    q_nope = q[..., :QK_NOPE_DIM]
    q_rope = apply_rope(q[..., QK_NOPE_DIM:], cos[:, None, :], sin[:, None, :])
    nblk = S // Q_BLOCK
    qn_b = q_nope.reshape(B, nblk, Q_BLOCK, N_HEADS, QK_NOPE_DIM).transpose(1, 0, 2, 3, 4)
    qr_b = q_rope.reshape(B, nblk, Q_BLOCK, N_HEADS, QK_ROPE_DIM).transpose(1, 0, 2, 3, 4)
    kpos = jnp.arange(S)
    sm_scale = QK_HEAD_DIM ** -0.5

    def attend_block(args):
        qn, qr, bi = args
        s = (jnp.einsum('bqhd,bkhd->bhqk', qn, k_nope)
             + jnp.einsum('bqhr,bkr->bhqk', qr, k_rope))
        s = s.astype(jnp.float32) * sm_scale
        qpos = bi * Q_BLOCK + jnp.arange(Q_BLOCK)
        s = jnp.where(qpos[:, None] >= kpos[None, :], s, -jnp.inf)
        p = jax.nn.softmax(s, axis=-1).astype(v.dtype)
        return jnp.einsum('bhqk,bkhd->bqhd', p, v)

    o = lax.map(attend_block, (qn_b, qr_b, jnp.arange(nblk)))
    o = o.transpose(1, 0, 2, 3, 4).reshape(B, S, N_HEADS * V_HEAD_DIM)
    return o @ w_o


def setup_inputs(seed: int = 0) -> dict:
    key = jax.random.key(seed)
    ks = jax.random.split(key, 24)
    f32 = jnp.float32
    nrm = lambda k, shape, s: jax.random.normal(k, shape, f32) * s
    gain = lambda k, shape: 1.0 + 0.02 * jax.random.normal(k, shape, f32)
    return {
        "x": jax.random.normal(ks[0], (BATCH, SEQ, D_MODEL), f32),
        "a_norm": gain(ks[1], (N_A, D_MODEL)),
        "a_pool_w": nrm(ks[2], (N_A, N_POOL_GROUPS, POOL_GROUP_DIM, POOL_GROUP_DIM), POOL_GROUP_DIM ** -0.5),
        "a_scale": 1.0 + 0.1 * jax.random.normal(ks[3], (N_A, D_MODEL), f32),
        "kv_norm": gain(ks[4], (D_MODEL,)),
        "w_dkv": nrm(ks[5], (D_MODEL, KV_LORA_RANK + QK_ROPE_DIM), D_MODEL ** -0.5),
        "kv_lat_norm": gain(ks[6], (KV_LORA_RANK,)),
        "w_ukv": nrm(ks[7], (KV_LORA_RANK, N_HEADS, QK_NOPE_DIM + V_HEAD_DIM), KV_LORA_RANK ** -0.5),
        "b_norm": gain(ks[8], (N_B, D_MODEL)),
        "w_dq": nrm(ks[9], (N_B, D_MODEL, Q_LORA_RANK), D_MODEL ** -0.5),
        "q_lat_norm": gain(ks[10], (N_B, Q_LORA_RANK)),
        "w_uq": nrm(ks[11], (N_B, Q_LORA_RANK, N_HEADS, QK_HEAD_DIM), Q_LORA_RANK ** -0.5),
        "w_o": nrm(ks[12], (N_B, N_HEADS * V_HEAD_DIM, D_MODEL), (N_HEADS * V_HEAD_DIM) ** -0.5),
        "ffn_norm": gain(ks[13], (DEPTH, D_MODEL)),
        "ffn_w_in": nrm(ks[14], (DEPTH, D_MODEL, 2 * D_FF), D_MODEL ** -0.5),
        "ffn_conv_w": nrm(ks[15], (DEPTH, CONV_WIDTH, 2 * D_FF), CONV_WIDTH ** -0.5),
        "ffn_conv_b": nrm(ks[16], (DEPTH, 2 * D_FF), 0.01),
        "ffn_w_out": nrm(ks[17], (DEPTH, D_FF, D_MODEL), D_FF ** -0.5),
        "final_norm": gain(ks[18], (D_MODEL,)),
    }


def reference(x, a_norm, a_pool_w, a_scale, kv_norm, w_dkv, kv_lat_norm, w_ukv,
              b_norm, w_dq, q_lat_norm, w_uq, w_o, ffn_norm, ffn_w_in, ffn_conv_w,
              ffn_conv_b, ffn_w_out, final_norm):
    S = x.shape[1]
    cos, sin = rope_tables(S, QK_ROPE_DIM, x.dtype)
    h = x
    shared = None
    for layer in range(DEPTH):
        if layer < N_A:
            h = h + multiscale_pool_mixer(rmsnorm(h, a_norm[layer]), a_pool_w[layer], a_scale[layer])
        else:
            j = layer - N_A
            k_nope, k_rope, v = shared
            h = h + mla_mixer(rmsnorm(h, b_norm[j]), w_dq[j], q_lat_norm[j], w_uq[j], w_o[j],
                              k_nope, k_rope, v, cos, sin)
        h = h + conv_ffn(rmsnorm(h, ffn_norm[layer]), ffn_w_in[layer], ffn_conv_w[layer],
                         ffn_conv_b[layer], ffn_w_out[layer])
        if layer == N_A - 1:
            shared = shared_latent_kv(h, kv_norm, w_dkv, kv_lat_norm, w_ukv, cos, sin)
    return rmsnorm(h, final_norm)
```

```cpp
#define MK_N_LAUNCHES 1
#define PG8_ALIGN_RES false
#include <hip/hip_runtime.h>
#include <cstdio>
#include <cstdint>
__device__ __forceinline__ int lane_id() { int l; asm volatile("v_mbcnt_lo_u32_b32 %0, -1, 0\n\tv_mbcnt_hi_u32_b32 %0, -1, %0" : "=v"(l)); return l; }
__device__ __forceinline__ float shfl_xor_f(float v, int m, int lane) { return __builtin_bit_cast(float, __builtin_amdgcn_ds_bpermute((lane ^ m) << 2, __builtin_bit_cast(int, v))); }
namespace pg8 {
#define PG8_LAS __attribute__((address_space(3)))
typedef unsigned short bf16_t;
typedef short bf16x8 __attribute__((ext_vector_type(8)));
typedef float f32x4 __attribute__((ext_vector_type(4)));
typedef unsigned u32x4 __attribute__((ext_vector_type(4)));
constexpr int BM = 256, BK = 64, HALF = 128, HTB = HALF * BK * 2  , STAGE_BYTES = 8 * HTB, NXCD = 8, WGM = 8;

__host__ __device__ __forceinline__ int lds_byte(int r, int c) { const int st = (r >> 4) * 2 + (c >> 5), rr = r & 15, cc = c & 31, ob = rr * 64 + cc * 2; return st * 1024 + (ob ^ (((ob >> 9) & 1) << 5)); }
__host__ __device__ __forceinline__ void stage_rc(int b, int& R, int& C) { const int st = b / 1024, sb = b % 1024, swz = sb ^ (((sb >> 9) & 1) << 5); R = (st >> 1) * 16 + swz / 64; C = (st & 1) * 32 + (swz % 64) / 2; }
__host__ __device__ __forceinline__ int perm32(int rho) { const int n = rho >> 4, i = rho & 15; return 8 * (i >> 2) + 4 * n + (i & 3); }

struct Unit { int pm, pn; };
struct Gemm { const bf16_t* A; const bf16_t* Bt; int M, N, K, lda; };

struct StaticOrder {
    int nM, nN, nwg, G, c, wgm = WGM;
    __host__ __device__ void init(int M, int N, int G_, int c_) { nM = M / BM; nN = N / BM; nwg = nM * nN; G = G_; c = c_; }
    __host__ __device__ bool next(int i, Unit& u) const {
        const long L = (long)i * G + c; if (L >= nwg) return false;
        int wgid = (int)L; { const int q = nwg / NXCD, r = nwg % NXCD, xcd = wgid % NXCD, off = wgid / NXCD; wgid = (xcd < r ? xcd * (q + 1) : r * (q + 1) + (xcd - r) * q) + off; }
        const int nig = wgm * nN, gid = wgid / nig, fm = gid * wgm, gsz = (nM - fm) < wgm ? (nM - fm) : wgm;
        u.pm = fm + ((wgid % nig) % gsz); u.pn = (wgid % nig) / gsz; return true;
    }
    __device__ __forceinline__ void a_ready(const Unit&) const {}
    __device__ __forceinline__ int acol(const Unit&) const { return 0; }
    __device__ __forceinline__ void done(const Unit&) const {}
};
__device__ __forceinline__ unsigned cvt_pk_bf16(float lo, float hi) { unsigned r; asm volatile("v_cvt_pk_bf16_f32 %0, %1, %2" : "=v"(r) : "v"(lo), "v"(hi)); return r; }
typedef float f32x2 __attribute__((ext_vector_type(2)));
struct PoolOrder : StaticOrder {
    __device__ __forceinline__ int acol(const Unit& u) const { return (u.pn >> 2) * 1024; }
};
struct EpiResF32 {
    static constexpr bool PERM = false, AFTER_DRAIN = false;
    float* C; const float* R; int ldc; const float* scale;
    __device__ __forceinline__ void operator()(const f32x4 (&acc)[2][2][4][2], const Unit& u, int wr, int wc, int fr, int fq) const {
        const int row0 = u.pm * BM + wr * 64 + fr, col0 = u.pn * BM + wc * 32 + 4 * fq;
        f32x4 sv[2][2];
#pragma unroll
        for (int bj = 0; bj < 2; ++bj)
#pragma unroll
            for (int n = 0; n < 2; ++n) sv[bj][n] = scale ? *(const f32x4*)(scale + col0 + bj * HALF + n * 16) : (f32x4){1.f, 1.f, 1.f, 1.f};
#pragma unroll
        for (int ai = 0; ai < 2; ++ai)
#pragma unroll
            for (int m = 0; m < 4; ++m) { const size_t ro = (size_t)(row0 + ai * HALF + m * 16) * ldc + col0; const float* rp = R + ro; float* cp = C + ro;
                f32x4 rv[2][2];
#pragma unroll
                for (int bj = 0; bj < 2; ++bj)
#pragma unroll
                    for (int n = 0; n < 2; ++n) rv[bj][n] = *(const f32x4*)(rp + bj * HALF + n * 16);
#pragma unroll
                for (int bj = 0; bj < 2; ++bj)
#pragma unroll
                    for (int n = 0; n < 2; ++n) *(f32x4*)(cp + bj * HALF + n * 16) = rv[bj][n] + acc[ai][bj][m][n] * sv[bj][n]; }
    }
};
struct EpiF32 {
    static constexpr bool PERM = false, AFTER_DRAIN = false;
    float* C; int ldc;
    __device__ __forceinline__ void operator()(const f32x4 (&acc)[2][2][4][2], const Unit& u, int wr, int wc, int fr, int fq) const {
        const int row0 = u.pm * BM + wr * 64 + fr, col0 = u.pn * BM + wc * 32 + 4 * fq;
#pragma unroll
        for (int ai = 0; ai < 2; ++ai)
#pragma unroll
            for (int m = 0; m < 4; ++m) { float* rowp = C + (size_t)(row0 + ai * HALF + m * 16) * ldc + col0;
#pragma unroll
                for (int bj = 0; bj < 2; ++bj)
#pragma unroll
                    for (int n = 0; n < 2; ++n) *(f32x4*)(rowp + bj * HALF + n * 16) = acc[ai][bj][m][n]; }
    }
};
struct EpiBf16 {
    static constexpr bool PERM = true, AFTER_DRAIN = false;
    bf16_t* O; int ldc;
    __device__ __forceinline__ void operator()(const f32x4 (&acc)[2][2][4][2], const Unit& u, int wr, int wc, int fr, int fq) const {
        const int row0 = u.pm * BM + wr * 64 + fr, col0 = u.pn * BM + wc * 32 + 8 * fq;
#pragma unroll
        for (int ai = 0; ai < 2; ++ai)
#pragma unroll
            for (int m = 0; m < 4; ++m) { bf16_t* rowp = O + (size_t)(row0 + ai * HALF + m * 16) * ldc + col0;
#pragma unroll
                for (int bj = 0; bj < 2; ++bj) { const f32x4 v0 = acc[ai][bj][m][0], v1 = acc[ai][bj][m][1];
                    u32x4 w; w.x = cvt_pk_bf16(v0[0], v0[1]); w.y = cvt_pk_bf16(v0[2], v0[3]); w.z = cvt_pk_bf16(v1[0], v1[1]); w.w = cvt_pk_bf16(v1[2], v1[3]);
                    *(u32x4*)(rowp + bj * HALF) = w; } }
    }
};
__device__ __forceinline__ float dpp_ror1(float v) { return __builtin_bit_cast(float, __builtin_amdgcn_update_dpp(0, __builtin_bit_cast(int, v), 0x121, 0xf, 0xf, false)); }
__device__ __forceinline__ float dpp_shr1_old(float old, float v) { return __builtin_bit_cast(float, __builtin_amdgcn_update_dpp(__builtin_bit_cast(int, old), __builtin_bit_cast(int, v), 0x111, 0xf, 0xf, false)); }
__device__ __forceinline__ float dpp_shr2_old(float old, float v) { return __builtin_bit_cast(float, __builtin_amdgcn_update_dpp(__builtin_bit_cast(int, old), __builtin_bit_cast(int, v), 0x112, 0xf, 0xf, false)); }
__device__ __forceinline__ float dpp_ror2(float v) { return __builtin_bit_cast(float, __builtin_amdgcn_update_dpp(0, __builtin_bit_cast(int, v), 0x122, 0xf, 0xf, false)); }
struct EpiResStat {
    static constexpr bool PERM = true, AFTER_DRAIN = false;
    const float* Rf; int ldc; const float* scale; bf16_t* HB; float* SSQ; bf16_t* HBout;
    __device__ __forceinline__ void operator()(const f32x4 (&acc)[2][2][4][2], const Unit& u, int wr, int wc, int fr, int fq) const {
        const int row0 = u.pm * BM + wr * 64 + fr, col0 = u.pn * BM + wc * 32 + 8 * fq, lane = fq * 16 + fr;
        f32x4 sv[2][2];
#pragma unroll
        for (int bj = 0; bj < 2; ++bj)
#pragma unroll
            for (int n = 0; n < 2; ++n) sv[bj][n] = scale ? *(const f32x4*)(scale + col0 + bj * HALF + 4 * n) : (f32x4){1.f, 1.f, 1.f, 1.f};
#pragma unroll
        for (int ai = 0; ai < 2; ++ai)
#pragma unroll
            for (int m = 0; m < 4; ++m) { const int row = row0 + ai * HALF + m * 16; const size_t ro = (size_t)row * ldc + col0;
                f32x4 rv[2][2]; float ss = 0.f;
                if (Rf) {
#pragma unroll
                    for (int bj = 0; bj < 2; ++bj)
#pragma unroll
                        for (int n = 0; n < 2; ++n) rv[bj][n] = *(const f32x4*)(Rf + ro + bj * HALF + 4 * n); }
                else {
#pragma unroll
                    for (int bj = 0; bj < 2; ++bj) { const u32x4 w = *(const u32x4*)(HB + ro + bj * HALF);
                        rv[bj][0] = (f32x4){__builtin_bit_cast(float, w.x << 16), __builtin_bit_cast(float, w.x & 0xffff0000u), __builtin_bit_cast(float, w.y << 16), __builtin_bit_cast(float, w.y & 0xffff0000u)};
                        rv[bj][1] = (f32x4){__builtin_bit_cast(float, w.z << 16), __builtin_bit_cast(float, w.z & 0xffff0000u), __builtin_bit_cast(float, w.w << 16), __builtin_bit_cast(float, w.w & 0xffff0000u)}; } }
#pragma unroll
                for (int bj = 0; bj < 2; ++bj) { const f32x4 h0 = rv[bj][0] + acc[ai][bj][m][0] * sv[bj][0], h1 = rv[bj][1] + acc[ai][bj][m][1] * sv[bj][1];
                    u32x4 w; w.x = cvt_pk_bf16(h0[0], h0[1]); w.y = cvt_pk_bf16(h0[2], h0[3]); w.z = cvt_pk_bf16(h1[0], h1[1]); w.w = cvt_pk_bf16(h1[2], h1[3]);
                    *(u32x4*)(HBout + ro + bj * HALF) = w;
                    ss += (h0[0] * h0[0] + h0[1] * h0[1]) + (h0[2] * h0[2] + h0[3] * h0[3]) + (h1[0] * h1[0] + h1[1] * h1[1]) + (h1[2] * h1[2] + h1[3] * h1[3]); }
                ss += shfl_xor_f(ss, 16, lane); ss += shfl_xor_f(ss, 32, lane);
                if (fq == 0) SSQ[(size_t)row * 64 + u.pn * 4 + wc] = ss; }
    }
};
struct EpiF32S {
    static constexpr bool PERM = false, AFTER_DRAIN = false;
    float* C; int ldc; const PG8_LAS float* RSL; int row_base;
    __device__ __forceinline__ void operator()(const f32x4 (&acc)[2][2][4][2], const Unit& u, int wr, int wc, int fr, int fq) const {
        const int row0 = u.pm * BM + wr * 64 + fr, col0 = u.pn * BM + wc * 32 + 4 * fq;
#pragma unroll
        for (int ai = 0; ai < 2; ++ai)
#pragma unroll
            for (int m = 0; m < 4; ++m) { const int row = row0 + ai * HALF + m * 16; const float rs = RSL[row - row_base]; float* rowp = C + (size_t)row * ldc + col0;
#pragma unroll
                for (int bj = 0; bj < 2; ++bj)
#pragma unroll
                    for (int n = 0; n < 2; ++n) *(f32x4*)(rowp + bj * HALF + n * 16) = acc[ai][bj][m][n] * rs; }
    }
};
struct EpiConvGate {
    static constexpr bool PERM = true, AFTER_DRAIN = false;
    bf16_t* G; const PG8_LAS float* RSL; int row_base; const float* cw; const float* cb; bf16_t* UE;
    __device__ __forceinline__ void operator()(const f32x4 (&acc)[2][2][4][2], const Unit& u, int wr, int wc, int fr, int fq) const {
        constexpr int DFF_ = 11008, NFF_ = 22016;
        const int row0 = u.pm * BM + wr * 64 + fr, jg0 = u.pn * HALF + wc * 32 + 8 * fq;
        const bool f01 = (fr < 2);
        f32x4 WG0[2], WG1[2], WG2[2], BG[2], WV0[2], WV1[2], WV2[2], BV[2];
#pragma unroll
        for (int n = 0; n < 2; ++n) { const int jg = jg0 + 4 * n;
            WG0[n] = *(const f32x4*)(cw + jg); WG1[n] = *(const f32x4*)(cw + NFF_ + jg); WG2[n] = *(const f32x4*)(cw + 2 * NFF_ + jg); BG[n] = *(const f32x4*)(cb + jg);
            WV0[n] = *(const f32x4*)(cw + DFF_ + jg); WV1[n] = *(const f32x4*)(cw + NFF_ + DFF_ + jg); WV2[n] = *(const f32x4*)(cw + 2 * NFF_ + DFF_ + jg); BV[n] = *(const f32x4*)(cb + DFF_ + jg); }
#pragma unroll
        for (int ai = 0; ai < 2; ++ai) {
            float rs[4];
#pragma unroll
            for (int m = 0; m < 4; ++m) rs[m] = RSL[row0 + ai * HALF + m * 16 - row_base];
            unsigned pk[4][4];
            const int run = (u.pm * BM + ai * HALF + wr * 64) >> 6;
#pragma unroll
            for (int n = 0; n < 2; ++n) { const int jg = jg0 + 4 * n;
                const f32x4 wg0 = WG0[n], wg1 = WG1[n], wg2 = WG2[n], bg = BG[n], wv0 = WV0[n], wv1 = WV1[n], wv2 = WV2[n], bv = BV[n];
                f32x4 ug[4], uv[4];
#pragma unroll
                for (int m = 0; m < 4; ++m) { ug[m] = acc[ai][0][m][n] * rs[m]; uv[m] = acc[ai][1][m][n] * rs[m]; }
                if (f01) { bf16_t* e = UE + ((size_t)run * 4 + fr) * NFF_ + jg; *(unsigned long long*)e = (unsigned long long)cvt_pk_bf16(ug[0][0], ug[0][1]) | ((unsigned long long)cvt_pk_bf16(ug[0][2], ug[0][3]) << 32);
                           *(unsigned long long*)(e + DFF_) = (unsigned long long)cvt_pk_bf16(uv[0][0], uv[0][1]) | ((unsigned long long)cvt_pk_bf16(uv[0][2], uv[0][3]) << 32); }
                if (fr >= 14) { bf16_t* e = UE + ((size_t)run * 4 + (fr - 12)) * NFF_ + jg; *(unsigned long long*)e = (unsigned long long)cvt_pk_bf16(ug[3][0], ug[3][1]) | ((unsigned long long)cvt_pk_bf16(ug[3][2], ug[3][3]) << 32);
                           *(unsigned long long*)(e + DFF_) = (unsigned long long)cvt_pk_bf16(uv[3][0], uv[3][1]) | ((unsigned long long)cvt_pk_bf16(uv[3][2], uv[3][3]) << 32); }
#pragma unroll
                for (int j = 0; j < 4; ++j) {
                    float g1p = 0.f, g2p = 0.f, v1p = 0.f, v2p = 0.f;
                    float gout[4];
#pragma unroll
                    for (int m = 0; m < 4; ++m) { const float xg = ug[m][j], xv = uv[m][j];
                        const float pg1 = dpp_shr1_old(g1p, xg), pg2 = dpp_shr2_old(g2p, xg), pv1 = dpp_shr1_old(v1p, xv), pv2 = dpp_shr2_old(v2p, xv);
                        if (m < 3) { g1p = dpp_ror1(xg); g2p = dpp_ror2(xg); v1p = dpp_ror1(xv); v2p = dpp_ror2(xv); }
                        const float gate = bg[j] + wg0[j] * pg2 + wg1[j] * pg1 + wg2[j] * xg, val = bv[j] + wv0[j] * pv2 + wv1[j] * pv1 + wv2[j] * xv;
                        gout[m] = gate * __builtin_amdgcn_rcpf(1.0f + __builtin_amdgcn_exp2f(-1.4426950408889634f * gate)) * val;
                    }
                    if (j & 1) {
#pragma unroll
                        for (int m = 0; m < 4; ++m) pk[m][2 * n + (j >> 1)] = cvt_pk_bf16(__builtin_bit_cast(float, pk[m][2 * n + (j >> 1)]), gout[m]); }
                    else {
#pragma unroll
                        for (int m = 0; m < 4; ++m) pk[m][2 * n + (j >> 1)] = __builtin_bit_cast(unsigned, gout[m]); }
                }
            }
#pragma unroll
            for (int m = 0; m < 4; ++m) { u32x4 w; w.x = pk[m][0]; w.y = pk[m][1]; w.z = pk[m][2]; w.w = pk[m][3];
                *(u32x4*)(G + (size_t)(row0 + ai * HALF + m * 16) * DFF_ + jg0) = w; }
        }
    }
};
template <class Epi, class Sched, bool ALIGN_EPI = false, bool SP2 = false>
__device__ __forceinline__ void gemm_phase(PG8_LAS unsigned char* lds, const Gemm g, const Sched& S, const Epi& E, const int wid_in  ) {
    int lane_l = lane_id(); asm volatile("" : "+v"(lane_l));
    int wid_l = wid_in; asm volatile("" : "+s"(wid_l));
    const int wid = wid_l, lane = lane_l, tid = wid * 64 + lane, wr = wid >> 2, wc = wid & 3, fr = lane & 15, fq = lane >> 4;
    const int K = g.K, nt = K / BK, lda = g.lda;
    unsigned voffA[2], voffB[2];
#pragma unroll
    for (int i = 0; i < 2; ++i) { int R, C; stage_rc(tid * 16 + i * 8192, R, C); const int Rb = Epi::PERM ? ((R & ~31) + perm32(R & 31)) : R;
        voffA[i] = (unsigned)(R * lda + C) * 2u; voffB[i] = (unsigned)(Rb * K + C) * 2u; }
    const size_t kstep = (size_t)(BK * 2);
    const size_t hsA = (size_t)HALF * lda * 2, hsB = (size_t)HALF * K * 2;
    const size_t tsA = 2 * hsA, tsB = 2 * hsB;
    const unsigned ldsw = (unsigned)wid * 1024u;
    const int aoff = lds_byte(wr * 64 + fr, fq * 8), boff = lds_byte(wc * 32 + fr, fq * 8);
#define PG8_SA(b, h) (((b) * 2 + (h)) * HTB)
#define PG8_SB(b, h) ((4 + (b) * 2 + (h)) * HTB)
#define PG8_STAGE(bufoff, gbase, voff) do { _Pragma("unroll") for (int _i = 0; _i < 2; ++_i) \
        __builtin_amdgcn_global_load_lds((const unsigned*)((const char*)(gbase) + (voff)[_i]), (PG8_LAS unsigned*)(lds + (bufoff) + ldsw + _i * 8192), 16, 0, 0); } while (0)
#define PG8_LDA(dst, b, h) do { _Pragma("unroll") for (int m = 0; m < 4; ++m) _Pragma("unroll") for (int k = 0; k < 2; ++k) dst[m][k] = *(const PG8_LAS bf16x8*)(lds + PG8_SA(b, h) + aoff + m * 2048 + k * 1024); } while (0)
#define PG8_LDB(dst, b, h) do { _Pragma("unroll") for (int n = 0; n < 2; ++n) _Pragma("unroll") for (int k = 0; k < 2; ++k) dst[n][k] = *(const PG8_LAS bf16x8*)(lds + PG8_SB(b, h) + boff + n * 2048 + k * 1024); } while (0)
#define PG8_MMA(ai, bj, At, Bt) do { __builtin_amdgcn_s_setprio(1); _Pragma("unroll") for (int m = 0; m < 4; ++m) _Pragma("unroll") for (int n = 0; n < 2; ++n) _Pragma("unroll") for (int k = 0; k < 2; ++k) \
        acc[ai][bj][m][n] = __builtin_amdgcn_mfma_f32_16x16x32_bf16(Bt[n][k], At[m][k], acc[ai][bj][m][n], 0, 0, 0); __builtin_amdgcn_s_setprio(0); } while (0)
#define PG8_WAIT_V(n) asm volatile("s_waitcnt vmcnt(" #n ")" ::: "memory")
#define PG8_WAIT_L(n) asm volatile("s_waitcnt lgkmcnt(" #n ")" ::: "memory")
#define PG8_BAR __builtin_amdgcn_s_barrier()
#define PG8_SCHED __builtin_amdgcn_sched_barrier(0)
    Unit cur, nxt; int ui = 0;
    if (!S.next(0, cur)) return;
    f32x4 acc[2][2][4][2];
#pragma unroll
    for (int a = 0; a < 2; ++a)
#pragma unroll
        for (int b = 0; b < 2; ++b)
#pragma unroll
            for (int m = 0; m < 4; ++m)
#pragma unroll
                for (int n = 0; n < 2; ++n) acc[a][b][m][n] = (f32x4){0.f, 0.f, 0.f, 0.f};
    bf16x8 At[4][2], B0[2][2], B1[2][2];
    const char* cA = (const char*)g.A + (size_t)cur.pm * tsA + (size_t)S.acol(cur) * 2; const char* cB = (const char*)g.Bt + (size_t)cur.pn * tsB;
    S.a_ready(cur);
    if constexpr (SP2) {
        PG8_STAGE(PG8_SB(0, 0), cB, voffB); PG8_STAGE(PG8_SB(0, 1), cB + hsB, voffB); PG8_STAGE(PG8_SA(0, 0), cA, voffA); PG8_STAGE(PG8_SA(0, 1), cA + hsA, voffA);
        if (wr == 1) PG8_BAR;
        PG8_WAIT_V(2); PG8_BAR;
        PG8_STAGE(PG8_SB(1, 0), cB + kstep, voffB); PG8_STAGE(PG8_SA(1, 0), cA + kstep, voffA); PG8_STAGE(PG8_SB(1, 1), cB + hsB + kstep, voffB);
        PG8_WAIT_V(6); PG8_BAR;
    } else {
        PG8_STAGE(PG8_SB(0, 0), cB, voffB); PG8_STAGE(PG8_SA(0, 0), cA, voffA); PG8_STAGE(PG8_SB(0, 1), cB + hsB, voffB); PG8_STAGE(PG8_SA(0, 1), cA + hsA, voffA);
        if (wr == 1) PG8_BAR;
        PG8_WAIT_V(4); PG8_BAR;
        PG8_STAGE(PG8_SB(1, 0), cB + kstep, voffB); PG8_STAGE(PG8_SA(1, 0), cA + kstep, voffA); PG8_STAGE(PG8_SB(1, 1), cB + hsB + kstep, voffB);
        PG8_WAIT_V(6); PG8_BAR;
    }
    for (;;) {
        const bool has_next = S.next(ui + 1, nxt);
        const char* nA = has_next ? (const char*)g.A + (size_t)nxt.pm * tsA + (size_t)S.acol(nxt) * 2 : cA; const char* nB = has_next ? (const char*)g.Bt + (size_t)nxt.pn * tsB : cB;
        for (int t = 0; t < nt; t += 2) {
            const bool last = (t == nt - 2);
            const char* a1 = cA + (size_t)(t + 1) * kstep;
            const char* a2 = last ? nA : cA + (size_t)(t + 2) * kstep; const char* b2 = last ? nB : cB + (size_t)(t + 2) * kstep;
            const char* a3 = a2 + kstep; const char* b3 = b2 + kstep;
            if (last && has_next) S.a_ready(nxt);
            if constexpr (SP2) {
            PG8_LDB(B0, 0, 0); PG8_LDB(B1, 0, 1); PG8_SCHED; PG8_LDA(At, 0, 0); PG8_STAGE(PG8_SA(1, 1), a1 + hsA, voffA);
            PG8_WAIT_V(8); PG8_WAIT_L(0); PG8_BAR; PG8_MMA(0, 0, At, B0); PG8_MMA(0, 1, At, B1); PG8_BAR; PG8_SCHED;
            PG8_LDA(At, 0, 1); PG8_STAGE(PG8_SB(0, 0), b2, voffB); PG8_STAGE(PG8_SB(0, 1), b2 + hsB, voffB); PG8_STAGE(PG8_SA(0, 0), a2, voffA);
            PG8_WAIT_V(8); PG8_WAIT_L(0); PG8_BAR; PG8_MMA(1, 0, At, B0); PG8_MMA(1, 1, At, B1); PG8_BAR; PG8_SCHED;
            PG8_LDB(B0, 1, 0); PG8_LDB(B1, 1, 1); PG8_SCHED; PG8_LDA(At, 1, 0); PG8_STAGE(PG8_SA(0, 1), a2 + hsA, voffA);
            PG8_WAIT_V(8); PG8_WAIT_L(0); PG8_BAR; PG8_MMA(0, 0, At, B0); PG8_MMA(0, 1, At, B1); PG8_BAR; PG8_SCHED;
            PG8_LDA(At, 1, 1); PG8_STAGE(PG8_SB(1, 0), b3, voffB); PG8_STAGE(PG8_SB(1, 1), b3 + hsB, voffB); PG8_STAGE(PG8_SA(1, 0), a3, voffA);
            PG8_WAIT_V(8); PG8_WAIT_L(0); PG8_BAR; PG8_MMA(1, 0, At, B0); PG8_MMA(1, 1, At, B1); PG8_BAR; PG8_SCHED;
            } else {
            PG8_LDB(B0, 0, 0); PG8_SCHED; PG8_LDA(At, 0, 0); PG8_STAGE(PG8_SA(1, 1), a1 + hsA, voffA);
            PG8_WAIT_L(8); PG8_BAR; PG8_WAIT_L(0); PG8_MMA(0, 0, At, B0); PG8_BAR; PG8_SCHED;
            PG8_LDB(B1, 0, 1); PG8_STAGE(PG8_SB(0, 0), b2, voffB);
            PG8_BAR; PG8_WAIT_L(0); PG8_MMA(0, 1, At, B1); PG8_BAR;
            PG8_LDA(At, 0, 1); PG8_STAGE(PG8_SA(0, 0), a2, voffA);
            PG8_BAR; PG8_WAIT_L(0); PG8_MMA(1, 0, At, B0); PG8_BAR; PG8_SCHED;
            PG8_STAGE(PG8_SB(0, 1), b2 + hsB, voffB);
            PG8_WAIT_V(6); PG8_BAR; PG8_MMA(1, 1, At, B1); PG8_BAR;
            PG8_LDB(B0, 1, 0); PG8_SCHED; PG8_LDA(At, 1, 0); PG8_STAGE(PG8_SA(0, 1), a2 + hsA, voffA);
            PG8_WAIT_L(8); PG8_BAR; PG8_WAIT_L(0); PG8_MMA(0, 0, At, B0); PG8_BAR; PG8_SCHED;
            PG8_LDB(B1, 1, 1); PG8_STAGE(PG8_SB(1, 0), b3, voffB);
            PG8_BAR; PG8_WAIT_L(0); PG8_MMA(0, 1, At, B1); PG8_BAR;
            PG8_LDA(At, 1, 1); PG8_STAGE(PG8_SA(1, 0), a3, voffA);
            PG8_BAR; PG8_WAIT_L(0); PG8_MMA(1, 0, At, B0); PG8_BAR; PG8_SCHED;
            PG8_STAGE(PG8_SB(1, 1), b3 + hsB, voffB);
            PG8_WAIT_V(6); PG8_BAR; PG8_MMA(1, 1, At, B1); PG8_BAR;
            }
        }
        if constexpr (ALIGN_EPI) { if (wr == 0) PG8_BAR; }
        if constexpr (!Epi::AFTER_DRAIN) { E(acc, cur, wr, wc, fr, fq); S.done(cur); }
        if (!has_next) break;
#pragma unroll
        for (int a = 0; a < 2; ++a)
#pragma unroll
            for (int b = 0; b < 2; ++b)
#pragma unroll
                for (int m = 0; m < 4; ++m)
#pragma unroll
                    for (int n = 0; n < 2; ++n) acc[a][b][m][n] = (f32x4){0.f, 0.f, 0.f, 0.f};
        cur = nxt; cA = nA; cB = nB; ++ui;
        if constexpr (ALIGN_EPI) { if (wr == 1) PG8_BAR; }
    }
    PG8_WAIT_V(0);
    if constexpr (!ALIGN_EPI) { if (wr == 0) PG8_BAR; }
    PG8_BAR;
    if constexpr (Epi::AFTER_DRAIN) { E.fused(acc, cur, wr, wc, fr, fq, lds, wid, lane); S.done(cur); }
#undef PG8_SA
#undef PG8_SB
#undef PG8_STAGE
#undef PG8_LDA
#undef PG8_LDB
#undef PG8_MMA
#undef PG8_WAIT_V
#undef PG8_WAIT_L
#undef PG8_BAR
#undef PG8_SCHED
}
}
namespace mla {
typedef unsigned short bf16;
typedef short bf16x8 __attribute__((ext_vector_type(8)));
typedef short s16x4 __attribute__((ext_vector_type(4)));
typedef float f32x4 __attribute__((ext_vector_type(4)));
typedef unsigned u32x4 __attribute__((ext_vector_type(4)));
typedef unsigned u32x2 __attribute__((ext_vector_type(2)));
typedef __attribute__((address_space(3))) unsigned char lds_uc;
constexpr int DQK = 192, DV = 128, NW = 8, QBLK = 32, KVBLK = 64, QB = NW * QBLK;
constexpr int PQ = 6144, PKV = 8192, PKR = 64, PO = 4096;
constexpr int KROW = 416, VROW = 288;
constexpr int KGR = KROW / 16, VGR = VROW / 16;
constexpr int SHM_K = KVBLK * KROW, SHM_V = KVBLK * VROW;
constexpr int NVB = 3, NKB = 2;
constexpr int OFF_V = 0, OFF_K = NVB * SHM_V, QX_OFF = OFF_K + NKB * SHM_K;
constexpr int LDS_BYTES = QX_OFF + NW * 4096;
constexpr float SCALE = 0.07216878364870322f, THR = 8.f;
constexpr float C2 = 1.4426950408889634f * SCALE;
#define SBAR() __builtin_amdgcn_sched_barrier(0)
#define VMW() asm volatile("s_waitcnt vmcnt(0)" ::: "memory")
#define GCH const __attribute__((address_space(1))) char
__device__ __forceinline__ unsigned cvtpk(float lo, float hi) { unsigned r; asm volatile("v_cvt_pk_bf16_f32 %0, %1, %2" : "=v"(r) : "v"(lo), "v"(hi)); return r; }
__device__ __forceinline__ float max3f(float a, float b, float c) { float r; asm("v_max3_f32 %0, %1, %2, %3" : "=v"(r) : "v"(a), "v"(b), "v"(c)); return r; }
__device__ __forceinline__ float max2f(float a, float b) { float r; asm("v_max_f32_e32 %0, %1, %2" : "=v"(r) : "v"(a), "v"(b)); return r; }
__device__ __forceinline__ float red16_max(float v) { auto r = __builtin_amdgcn_permlane16_swap(__float_as_uint(v), __float_as_uint(v), false, false); v = max2f(__uint_as_float(r[0]), __uint_as_float(r[1]));
    auto q = __builtin_amdgcn_permlane32_swap(__float_as_uint(v), __float_as_uint(v), false, false); return max2f(__uint_as_float(q[0]), __uint_as_float(q[1])); }
__device__ __forceinline__ float red16_sum(float v) { auto r = __builtin_amdgcn_permlane16_swap(__float_as_uint(v), __float_as_uint(v), false, false); v = __uint_as_float(r[0]) + __uint_as_float(r[1]);
    auto q = __builtin_amdgcn_permlane32_swap(__float_as_uint(v), __float_as_uint(v), false, false); return __uint_as_float(q[0]) + __uint_as_float(q[1]); }
struct Tensors { const bf16* Q; const bf16* KV; const bf16* KR; bf16* O; const float* T; };
struct BlockRef { const bf16* Q; const bf16* Kn; bf16* O; int P0; int desc; };
struct Seam { bf16x8 qf[2][4]; int g, vs; };
struct DmaOff { unsigned k[4], v[3]; };
__device__ __forceinline__ DmaOff dma_offsets(int wid, int lane) {
    DmaOff d;
#pragma unroll
    for (int i = 0; i < 4; ++i) { const int L = (i * 8 + wid) * 64 + lane, row = L / KGR, pc = L - row * KGR, c = pc < 24 ? pc : 0;
        d.k[i] = c < 16 ? (unsigned)(row * (PKV * 2) + c * 16) : (0x80000000u | (unsigned)(row * (PKR * 2) + (c - 16) * 16)); }
#pragma unroll
    for (int i = 0; i < 3; ++i) { const int L = (i * 8 + wid) * 64 + lane, row = L / VGR, pc = L - row * VGR, c = pc < 16 ? pc : 0;
        d.v[i] = (unsigned)(row * (PKV * 2) + c * 16) + 256u; }
    return d;
}
__device__ __forceinline__ void dma_tile(const bf16* Kn, const bf16* Kr, int k0, int ks, int vs, lds_uc* ldsl, int wid, const DmaOff& d) {
    typedef __attribute__((address_space(3))) unsigned LU;
    const char* kvb = (const char*)Kn + (size_t)k0 * (PKV * 2); const char* krb = (const char*)Kr + (size_t)k0 * (PKR * 2);
#pragma unroll
    for (int i = 0; i < 4; ++i) { if (i == 3 && wid >= 2) break;
        const char* src = ((int)d.k[i] < 0 ? krb : kvb) + (d.k[i] & 0x7fffffffu);
        __builtin_amdgcn_global_load_lds((const unsigned*)src, (LU*)(ldsl + OFF_K + ks * SHM_K + (i * 8 + wid) * 1024), 16, 0, 0); }
#pragma unroll
    for (int i = 0; i < 3; ++i) { if (i == 2 && wid >= 2) break;
        __builtin_amdgcn_global_load_lds((const unsigned*)(kvb + d.v[i]), (LU*)(ldsl + OFF_V + vs * SHM_V + (i * 8 + wid) * 1024), 16, 0, 0); }
}
struct DmaReq { const bf16* Kn; const bf16* Kr; int k0, ks, vs; lds_uc* ldsl; int wid; bool on; };
__device__ __forceinline__ void qkt(f32x4 (&st)[4][2], const char* klb, const bf16x8 (&qf)[2][4], const char* qx, const DmaReq& rq_, const DmaOff& doff_) {
#pragma unroll
    for (int i = 0; i < 4; ++i) { st[i][0] = (f32x4){0.f, 0.f, 0.f, 0.f}; st[i][1] = (f32x4){0.f, 0.f, 0.f, 0.f}; }
#define KLD(n, dst) do { dst = *reinterpret_cast<const bf16x8*>(klb + ((n) & 3) * 16 * KROW + ((n) >> 2) * 64); } while (0)
    bf16x8 k0, k1, k2, k3, q4a, q4b, q5a, q5b;
    KLD(0, k0); KLD(1, k1); KLD(2, k2); KLD(3, k3); SBAR();
#pragma unroll
    for (int s = 0; s < 6; ++s) {
        if (s == 3) { q4a = *reinterpret_cast<const bf16x8*>(qx); q4b = *reinterpret_cast<const bf16x8*>(qx + 1024); }
        if (s == 4) { q5a = *reinterpret_cast<const bf16x8*>(qx + 2048); q5b = *reinterpret_cast<const bf16x8*>(qx + 3072); }
        SBAR();
        const bf16x8 qa = s < 4 ? qf[0][s < 4 ? s : 0] : (s == 4 ? q4a : q5a), qb = s < 4 ? qf[1][s < 4 ? s : 0] : (s == 4 ? q4b : q5b);
#define SLOT(i, kk) do { st[i][0] = __builtin_amdgcn_mfma_f32_16x16x32_bf16(kk, qa, st[i][0], 0, 0, 0); st[i][1] = __builtin_amdgcn_mfma_f32_16x16x32_bf16(kk, qb, st[i][1], 0, 0, 0); \
            SBAR(); if (s < 5) KLD(4 * (s + 1) + (i), kk); SBAR(); } while (0)
        SLOT(0, k0); SLOT(1, k1); SLOT(2, k2); SLOT(3, k3);
#undef SLOT
        if (s == 0) { if (rq_.on) dma_tile(rq_.Kn, rq_.Kr, rq_.k0, rq_.ks, rq_.vs, rq_.ldsl, rq_.wid, doff_); SBAR(); }
    }
#undef KLD
}
__device__ __forceinline__ void mask_tile(f32x4 (&st)[4][2], int dq0, int dq1) {
    const float NEG = -__builtin_inff();
#pragma unroll
    for (int i = 0; i < 4; ++i)
#pragma unroll
        for (int r = 0; r < 4; ++r) { if (16 * i + r > dq0) st[i][0][r] = NEG; if (16 * i + r > dq1) st[i][1][r] = NEG; }
}
__device__ __forceinline__ bool partialSM(f32x4 (&st)[4][2], float (&m)[2], float (&al)[2]) {
    float pm[2];
#pragma unroll
    for (int j = 0; j < 2; ++j) { float a = max3f(st[0][j][0], st[0][j][1], st[0][j][2]), b = max3f(st[0][j][3], st[1][j][0], st[1][j][1]);
        a = max3f(a, st[1][j][2], st[1][j][3]); b = max3f(b, st[2][j][0], st[2][j][1]); a = max3f(a, st[2][j][2], st[2][j][3]); b = max3f(b, st[3][j][0], st[3][j][1]); a = max3f(a, st[3][j][2], st[3][j][3]);
        pm[j] = max2f(a, b); }
    float mn[2];
    const bool keep = __all((pm[0] - m[0]) * SCALE <= THR && (pm[1] - m[1]) * SCALE <= THR);
    if (__builtin_expect(keep, 1)) { mn[0] = m[0]; mn[1] = m[1]; al[0] = 1.f; al[1] = 1.f; }
    else {
#pragma unroll
        for (int j = 0; j < 2; ++j) { mn[j] = max2f(m[j], red16_max(pm[j])); al[j] = __builtin_amdgcn_exp2f((m[j] - mn[j]) * C2); m[j] = mn[j]; } }
#pragma unroll
    for (int j = 0; j < 2; ++j) { const float mnL = -mn[j] * C2;
#pragma unroll
        for (int i = 0; i < 4; ++i)
#pragma unroll
            for (int r = 0; r < 4; ++r) st[i][j][r] = fmaf(st[i][j][r], C2, mnL); }
#pragma unroll
    for (int i = 0; i < 4; ++i)
#pragma unroll
        for (int r = 0; r < 4; ++r) st[i][0][r] = __builtin_amdgcn_exp2f(st[i][0][r]);
    return keep;
}
__device__ __forceinline__ void finishSM(f32x4 (&st)[4][2], bf16x8 (&pb)[2][2]) {
#pragma unroll
    for (int i = 0; i < 4; ++i)
#pragma unroll
        for (int r = 0; r < 4; ++r) st[i][1][r] = __builtin_amdgcn_exp2f(st[i][1][r]);
#pragma unroll
    for (int j = 0; j < 2; ++j)
#pragma unroll
        for (int b = 0; b < 2; ++b) { u32x4 w = {cvtpk(st[2 * b][j][0], st[2 * b][j][1]), cvtpk(st[2 * b][j][2], st[2 * b][j][3]), cvtpk(st[2 * b + 1][j][0], st[2 * b + 1][j][1]), cvtpk(st[2 * b + 1][j][2], st[2 * b + 1][j][3])};
            pb[j][b] = *reinterpret_cast<bf16x8*>(&w); }
}
__device__ __forceinline__ void pv_tile(f32x4 (&ot)[8][2], f32x4 (&lt)[2], int vb0, const bf16x8 (&pb)[2][2]) {
#define TRRD(dst, off) asm volatile("ds_read_b64_tr_b16 %0, %1 offset:%2" : "=&v"(dst) : "v"(vb0), "i"(off) : "memory")
#define PV_RD(n, lo, hi) do { SBAR(); TRRD(lo, ((n) >> 3) * 32 * VROW + ((n) & 7) * 32); TRRD(hi, ((n) >> 3) * 32 * VROW + 16 * VROW + ((n) & 7) * 32); SBAR(); } while (0)
#define PV_W(k) do { asm volatile("s_waitcnt lgkmcnt(" #k ")" ::: "memory"); SBAR(); } while (0)
#define PV_MM(n, lo, hi) do { const bf16x8 vf_ = {lo[0], lo[1], lo[2], lo[3], hi[0], hi[1], hi[2], hi[3]};                                  \
        ot[(n) & 7][0] = __builtin_amdgcn_mfma_f32_16x16x32_bf16(vf_, pb[0][(n) >> 3], ot[(n) & 7][0], 0, 0, 0);                           \
        ot[(n) & 7][1] = __builtin_amdgcn_mfma_f32_16x16x32_bf16(vf_, pb[1][(n) >> 3], ot[(n) & 7][1], 0, 0, 0); SBAR(); } while (0)
    s16x4 al_, ah_, bl_, bh_, cl_, ch_, dl_, dh_;
    PV_RD(0, al_, ah_); PV_RD(1, bl_, bh_); PV_RD(2, cl_, ch_);
    { const bf16x8 ones_ = {0x3F80, 0x3F80, 0x3F80, 0x3F80, 0x3F80, 0x3F80, 0x3F80, 0x3F80};
      lt[0] = __builtin_amdgcn_mfma_f32_16x16x32_bf16(ones_, pb[0][0], lt[0], 0, 0, 0); lt[1] = __builtin_amdgcn_mfma_f32_16x16x32_bf16(ones_, pb[1][0], lt[1], 0, 0, 0);
      lt[0] = __builtin_amdgcn_mfma_f32_16x16x32_bf16(ones_, pb[0][1], lt[0], 0, 0, 0); lt[1] = __builtin_amdgcn_mfma_f32_16x16x32_bf16(ones_, pb[1][1], lt[1], 0, 0, 0); SBAR(); }
#pragma unroll
    for (int n = 0; n < 16; n += 4) {
        PV_RD(n + 3, dl_, dh_); PV_W(6); PV_MM(n, al_, ah_);
        if (n + 4 < 16) { PV_RD(n + 4, al_, ah_); PV_W(6); } else PV_W(4);
        PV_MM(n + 1, bl_, bh_);
        if (n + 5 < 16) { PV_RD(n + 5, bl_, bh_); PV_W(6); } else PV_W(2);
        PV_MM(n + 2, cl_, ch_);
        if (n + 6 < 16) { PV_RD(n + 6, cl_, ch_); PV_W(6); } else PV_W(0);
        PV_MM(n + 3, dl_, dh_);
    }
#undef TRRD
#undef PV_RD
#undef PV_W
#undef PV_MM
}
__device__ __forceinline__ bool pv_ps(f32x4 (&ot)[8][2], f32x4 (&lt)[2], int vb0, const bf16x8 (&pb)[2][2], f32x4 (&x)[4][2], float (&m)[2], float (&al)[2]) {
#define TRRD(dst, off) asm volatile("ds_read_b64_tr_b16 %0, %1 offset:%2" : "=&v"(dst) : "v"(vb0), "i"(off) : "memory")
#define PV_RD(n, lo, hi) do { SBAR(); TRRD(lo, ((n) >> 3) * 32 * VROW + ((n) & 7) * 32); TRRD(hi, ((n) >> 3) * 32 * VROW + 16 * VROW + ((n) & 7) * 32); SBAR(); } while (0)
#define PV_W(k) do { asm volatile("s_waitcnt lgkmcnt(" #k ")" ::: "memory"); SBAR(); } while (0)
#define PV_MM(n, lo, hi) do { const bf16x8 vf_ = {lo[0], lo[1], lo[2], lo[3], hi[0], hi[1], hi[2], hi[3]};                                  \
        ot[(n) & 7][0] = __builtin_amdgcn_mfma_f32_16x16x32_bf16(vf_, pb[0][(n) >> 3], ot[(n) & 7][0], 0, 0, 0);                           \
        ot[(n) & 7][1] = __builtin_amdgcn_mfma_f32_16x16x32_bf16(vf_, pb[1][(n) >> 3], ot[(n) & 7][1], 0, 0, 0); } while (0)
    s16x4 al_, ah_, bl_, bh_, cl_, ch_, dl_, dh_;
    float pa0, pb0, pa1, pb1, mn[2] = {0.f, 0.f}, mnL0 = 0.f, mnL1 = 0.f; bool keep = true;
    PV_RD(0, al_, ah_); PV_RD(1, bl_, bh_); PV_RD(2, cl_, ch_);
    { const bf16x8 ones_ = {0x3F80, 0x3F80, 0x3F80, 0x3F80, 0x3F80, 0x3F80, 0x3F80, 0x3F80};
      lt[0] = __builtin_amdgcn_mfma_f32_16x16x32_bf16(ones_, pb[0][0], lt[0], 0, 0, 0); lt[1] = __builtin_amdgcn_mfma_f32_16x16x32_bf16(ones_, pb[1][0], lt[1], 0, 0, 0);
      lt[0] = __builtin_amdgcn_mfma_f32_16x16x32_bf16(ones_, pb[0][1], lt[0], 0, 0, 0); lt[1] = __builtin_amdgcn_mfma_f32_16x16x32_bf16(ones_, pb[1][1], lt[1], 0, 0, 0); SBAR(); }
#define FILL(n) do { \
        if ((n) == 0) { pa0 = max3f(x[0][0][0], x[0][0][1], x[0][0][2]); pb0 = max3f(x[0][0][3], x[1][0][0], x[1][0][1]); pa0 = max3f(pa0, x[1][0][2], x[1][0][3]); pb0 = max3f(pb0, x[2][0][0], x[2][0][1]); } \
        if ((n) == 1) { pa0 = max3f(pa0, x[2][0][2], x[2][0][3]); pb0 = max3f(pb0, x[3][0][0], x[3][0][1]); pa0 = max3f(pa0, x[3][0][2], x[3][0][3]); pa0 = max2f(pa0, pb0); } \
        if ((n) == 2) { pa1 = max3f(x[0][1][0], x[0][1][1], x[0][1][2]); pb1 = max3f(x[0][1][3], x[1][1][0], x[1][1][1]); pa1 = max3f(pa1, x[1][1][2], x[1][1][3]); pb1 = max3f(pb1, x[2][1][0], x[2][1][1]); } \
        if ((n) == 3) { pa1 = max3f(pa1, x[2][1][2], x[2][1][3]); pb1 = max3f(pb1, x[3][1][0], x[3][1][1]); pa1 = max3f(pa1, x[3][1][2], x[3][1][3]); pa1 = max2f(pa1, pb1); \
            keep = __all((pa0 - m[0]) * SCALE <= THR && (pa1 - m[1]) * SCALE <= THR); \
            if (__builtin_expect(keep, 1)) { mn[0] = m[0]; mn[1] = m[1]; al[0] = 1.f; al[1] = 1.f; } \
            else { mn[0] = max2f(m[0], red16_max(pa0)); al[0] = __builtin_amdgcn_exp2f((m[0] - mn[0]) * C2); m[0] = mn[0]; mn[1] = max2f(m[1], red16_max(pa1)); al[1] = __builtin_amdgcn_exp2f((m[1] - mn[1]) * C2); m[1] = mn[1]; } \
            mnL0 = -mn[0] * C2; mnL1 = -mn[1] * C2; } \
        if ((n) >= 4 && (n) < 8) { const int i_ = (n) - 4; x[i_][0][0] = fmaf(x[i_][0][0], C2, mnL0); x[i_][0][1] = fmaf(x[i_][0][1], C2, mnL0); x[i_][0][2] = fmaf(x[i_][0][2], C2, mnL0); x[i_][0][3] = fmaf(x[i_][0][3], C2, mnL0); } \
        if ((n) >= 8 && (n) < 12) { const int i_ = (n) - 8; x[i_][1][0] = fmaf(x[i_][1][0], C2, mnL1); x[i_][1][1] = fmaf(x[i_][1][1], C2, mnL1); x[i_][1][2] = fmaf(x[i_][1][2], C2, mnL1); x[i_][1][3] = fmaf(x[i_][1][3], C2, mnL1); } \
        if ((n) >= 12) { const int i_ = (n) - 12; x[i_][0][0] = __builtin_amdgcn_exp2f(x[i_][0][0]); x[i_][0][1] = __builtin_amdgcn_exp2f(x[i_][0][1]); x[i_][0][2] = __builtin_amdgcn_exp2f(x[i_][0][2]); x[i_][0][3] = __builtin_amdgcn_exp2f(x[i_][0][3]); } \
        SBAR(); } while (0)
#pragma unroll
    for (int n = 0; n < 16; n += 4) {
        PV_RD(n + 3, dl_, dh_); PV_W(6); PV_MM(n, al_, ah_); FILL(n);
        if (n + 4 < 16) { PV_RD(n + 4, al_, ah_); PV_W(6); } else PV_W(4);
        PV_MM(n + 1, bl_, bh_); FILL(n + 1);
        if (n + 5 < 16) { PV_RD(n + 5, bl_, bh_); PV_W(6); } else PV_W(2);
        PV_MM(n + 2, cl_, ch_); FILL(n + 2);
        if (n + 6 < 16) { PV_RD(n + 6, cl_, ch_); PV_W(6); } else PV_W(0);
        PV_MM(n + 3, dl_, dh_); FILL(n + 3);
    }
#undef TRRD
#undef PV_RD
#undef PV_W
#undef PV_MM
#undef FILL
    return keep;
}
__device__ __forceinline__ void rope2(bf16x8& x1f, bf16x8& x2f, const f32x4 (&cs)[4]) {
    u32x4 x1 = *reinterpret_cast<u32x4*>(&x1f), x2 = *reinterpret_cast<u32x4*>(&x2f), o1, o2;
#pragma unroll
    for (int p = 0; p < 4; ++p) { const f32x4 t = cs[p];
        const float a0 = __builtin_bit_cast(float, x1[p] << 16), a1 = __builtin_bit_cast(float, x1[p] & 0xffff0000u), b0 = __builtin_bit_cast(float, x2[p] << 16), b1 = __builtin_bit_cast(float, x2[p] & 0xffff0000u);
        o1[p] = cvtpk(a0 * t[0] - b0 * t[1], a1 * t[2] - b1 * t[3]); o2[p] = cvtpk(b0 * t[0] + a0 * t[1], b1 * t[2] + a1 * t[3]); }
    x1f = *reinterpret_cast<bf16x8*>(&o1); x2f = *reinterpret_cast<bf16x8*>(&o2);
}
#define LD8G(base, voff) (*(const __attribute__((address_space(1))) bf16x8*)((GCH*)(base) + (voff)))
#define LDT(base, voff) (*(const __attribute__((address_space(1))) f32x4*)((GCH*)(base) + (voff)))
#define QLOADS(R_) do { const int ln_ = lane_id(), c_ = ln_ & 15, g_ = ln_ >> 4;                                                                                     \
        _Pragma("unroll") for (int j_ = 0; j_ < 2; ++j_) { const unsigned voq_ = (unsigned)((wid * QBLK + 16 * j_ + c_) * PQ + 8 * g_) * 2u;                       \
            const unsigned vt_ = (unsigned)(((R_).P0 + wid * QBLK + 16 * j_ + c_) * 256 + g_ * 64);                                                                 \
            rq[j_][0] = LD8G((R_).Q, voq_ + 256); rq[j_][1] = LD8G((R_).Q, voq_ + 320);                                                                            \
            _Pragma("unroll") for (int p_ = 0; p_ < 4; ++p_) cs[j_][p_] = LDT(Tn.T, vt_ + 16 * p_);                                                                \
            _Pragma("unroll") for (int s_ = 0; s_ < 4; ++s_) S.qf[j_][s_] = LD8G((R_).Q, voq_ + 64 * s_); } } while (0)
#define QFIN() do { _Pragma("unroll") for (int j_ = 0; j_ < 2; ++j_) { rope2(rq[j_][0], rq[j_][1], cs[j_]);                                                      \
            *(bf16x8*)(qx + j_ * 1024) = rq[j_][0]; *(bf16x8*)(qx + 2048 + j_ * 1024) = rq[j_][1]; } } while (0)
#define VNEXT(v) ((v) == 2 ? 0 : (v) + 1)
#define FIRST_K0(R_) ((R_).desc ? (((R_).P0 + QB - 1) / KVBLK) * KVBLK : 0)
__device__ __forceinline__ void prime(const Tensors& Tn, const BlockRef& cur, char* lds, lds_uc* ldsl, Seam& S, const int wid_in) {
    int lane_l = lane_id(); asm volatile("" : "+v"(lane_l));
    int wid_l = wid_in; asm volatile("" : "+s"(wid_l));
    const int wid = wid_l, lane = lane_l;
    char* qx = lds + QX_OFF + wid * 4096 + lane * 16; bf16x8 rq[2][2]; f32x4 cs[2][4];
    S.g = 0; S.vs = 0;
    { const DmaOff d0_ = dma_offsets(wid, lane); dma_tile(cur.Kn, Tn.KR, FIRST_K0(cur), 0, 0, ldsl, wid, d0_); }
    QLOADS(cur);
    VMW();
    QFIN();
    __syncthreads();
}
__device__ __forceinline__ void block(const Tensors& Tn, const BlockRef& cur, const BlockRef& nxt, const bool has_nxt, char* lds, lds_uc* ldsl, Seam& S, const int wid_in) {
    int lane_l = lane_id(); asm volatile("" : "+v"(lane_l));
    int wid_l = wid_in; asm volatile("" : "+s"(wid_l));
    const int wid = wid_l, lane = lane_l, c = lane & 15, g = lane >> 4;
    const int NT = (cur.P0 + QB - 1) / KVBLK + 1;
    const int qlo = cur.P0 + wid * QBLK, dqb = qlo + c - 4 * g;
    const char* klb0 = lds + OFF_K + c * KROW + 16 * g;
    const int vbb = (int)(uintptr_t)(lds + OFF_V) + (4 * g + (c >> 2)) * VROW + 8 * (lane & 3);
    char* qx = lds + QX_OFF + wid * 4096 + lane * 16;
    float m[2] = {-1e30f, -1e30f}; f32x4 ot[8][2], lt[2] = {(f32x4){0.f, 0.f, 0.f, 0.f}, (f32x4){0.f, 0.f, 0.f, 0.f}};
#pragma unroll
    for (int t = 0; t < 8; ++t) { ot[t][0] = (f32x4){0.f, 0.f, 0.f, 0.f}; ot[t][1] = (f32x4){0.f, 0.f, 0.f, 0.f}; }
    const DmaOff doff = dma_offsets(wid, lane);
    const int gt0 = S.g; int vp = S.vs;
#define KBASE(t) ((cur.desc ? NT - 1 - (t) : (t)) * KVBLK)
#define KSLOT(t) (klb0 + ((gt0 + (t)) & 1) * SHM_K)
#define MASKT(X, t) do { const int kb_ = KBASE(t); if (kb_ + KVBLK - 1 > qlo) mask_tile(X, dqb - kb_, dqb + 16 - kb_); } while (0)
#define RESC(keep_, a) do { if (!(keep_)) { _Pragma("unroll") for (int t_ = 0; t_ < 8; ++t_) { ot[t_][0] *= (a)[0]; ot[t_][1] *= (a)[1]; } lt[0] *= (a)[0]; lt[1] *= (a)[1]; } } while (0)
    f32x4 pA[4][2], pB[4][2]; float alA[2], alB[2]; bf16x8 pb[2][2];
    { const DmaReq rq0_{cur.Kn, Tn.KR, KBASE(1), (gt0 + 1) & 1, VNEXT(vp), ldsl, wid, true}; qkt(pA, KSLOT(0), S.qf, qx, rq0_, doff); }
    MASKT(pA, 0); { const bool kp_ = partialSM(pA, m, alA); RESC(kp_, alA); }
    VMW(); __syncthreads();
#define STEP(PX, alX, PY, alY, t) do { (void)alY;                                                                              \
        { const int vd_ = vp == 0 ? 2 : vp - 1; const bool in_ = (t) + 1 < NT;     \
          const DmaReq rq_{in_ ? cur.Kn : nxt.Kn, Tn.KR, in_ ? KBASE((t) + 1) : FIRST_K0(nxt), (gt0 + (t) + 1) & 1, vd_, ldsl, wid, in_ || has_nxt}; \
          SBAR(); qkt(PX, KSLOT(t), S.qf, qx, rq_, doff); }                                                                     \
        finishSM(PY, pb); SBAR();                                                                                              \
        MASKT(PX, (t));                                                            \
        { const bool kp_ = pv_ps(ot, lt, vbb + vp * SHM_V, pb, PX, m, alX); vp = VNEXT(vp); RESC(kp_, alX); }                  \
        VMW(); __syncthreads(); } while (0)
    for (int t = 1; t + 1 < NT; t += 2) {
        STEP(pB, alB, pA, alA, t);
        STEP(pA, alA, pB, alB, t + 1);
    }
    STEP(pB, alB, pA, alA, NT - 1);
    bf16x8 rq[2][2]; f32x4 cs[2][4];
    if (has_nxt) QLOADS(nxt);
    SBAR();
    finishSM(pB, pb); SBAR();
    pv_tile(ot, lt, vbb + vp * SHM_V, pb); vp = VNEXT(vp);
    SBAR();
    if (has_nxt) { VMW(); QFIN(); }
    S.g = gt0 + NT; S.vs = vp;
    { const float rl0 = __builtin_amdgcn_rcpf(lt[0][0]), rl1 = __builtin_amdgcn_rcpf(lt[1][0]);
      __attribute__((address_space(1))) char* Ob = (__attribute__((address_space(1))) char*)cur.O; const unsigned voo = (unsigned)((wid * QBLK + c) * PO + 4 * g) * 2u;
#pragma unroll
      for (int t = 0; t < 8; ++t) { const f32x4 a = ot[t][0] * rl0, b = ot[t][1] * rl1;
          *(__attribute__((address_space(1))) u32x2*)(Ob + (voo + (unsigned)(16 * t) * 2u)) = (u32x2){cvtpk(a[0], a[1]), cvtpk(a[2], a[3])};
          *(__attribute__((address_space(1))) u32x2*)(Ob + (voo + (unsigned)(16 * PO + 16 * t) * 2u)) = (u32x2){cvtpk(b[0], b[1]), cvtpk(b[2], b[3])}; } }
#undef KBASE
#undef KSLOT
#undef MASKT
#undef RESC
#undef STEP
}
#undef QLOADS
#undef QFIN
#undef VNEXT
#undef FIRST_K0
#undef LD8G
#undef LDT
#undef GCH
#undef VMW
__device__ __forceinline__ BlockRef mkref(const Tensors& T, int L, int pass) {
    const int xcd = L & 7, k = L >> 3, h = (k >> 5) * 8 + xcd, x = k & 31, qb = pass ? x : 63 - x;
    BlockRef r; r.Q = T.Q + (size_t)qb * QB * PQ + h * DQK; r.Kn = T.KV + h * 256; r.O = T.O + (size_t)qb * QB * PO + h * DV; r.P0 = qb * QB; r.desc = pass; return r;
}
__device__ __forceinline__ void attn_phase(char* lds, lds_uc* ldsl, const Tensors& T, int G, int c, const int wid_in) {
    constexpr int total = 1024;
    int L = c; if (L >= total) return;
    int pass = 0; BlockRef cur = mkref(T, L, 0);
    if (wid_in >= 4) __builtin_amdgcn_s_setprio(1);
    Seam S; prime(T, cur, lds, ldsl, S, wid_in);
    for (;;) {
        const bool more_pass = pass == 0, more_item = L + G < total, last = !more_pass && !more_item;
        int passn = pass + 1, Ln = L; if (!more_pass) { passn = 0; Ln = more_item ? L + G : L; }
        const BlockRef nxt = last ? cur : mkref(T, Ln, passn);
        block(T, cur, nxt, !last, lds, ldsl, S, wid_in);
        if (last) break;
        cur = nxt; pass = passn; L = Ln;
    }
    __builtin_amdgcn_s_setprio(0);
}
}
constexpr int NWAVES = 8;
constexpr int S_ = 16384, DM = 4096, DFF = 11008, NFF = 22016, NH = 32;
constexpr int NDKVQ = 1792;
constexpr float EPS = 1e-6f;
constexpr int NPH = 14;
#ifndef MK_N_LAUNCHES
#define MK_N_LAUNCHES 1
#endif
constexpr int N_LAUNCHES = MK_N_LAUNCHES;
constexpr size_t MiB = 1u << 20;
constexpr size_t WS_CTL = 0, CTL_ZERO_BYTES = 64 * 1024;
constexpr size_t WS_ROPE = 2 * MiB;
constexpr size_t WS_WPOOL = 8 * MiB, WS_WDKVQ = 16 * MiB, WS_WUKV = 30 * MiB, WS_WUQ = 38 * MiB, WS_WO = 50 * MiB, WS_WIN = 82 * MiB, WS_WOUT = 426 * MiB;
constexpr size_t WIN_L = 172 * MiB, WOUT_L = 86 * MiB;
constexpr size_t WS_H = 598 * MiB;
constexpr size_t WS_XN = 854 * MiB;
constexpr size_t WS_XPB = 982 * MiB;
constexpr size_t WS_UE = 1600 * MiB;
constexpr size_t WS_SSQ = 1644 * MiB;
constexpr size_t WS_DUMMY2 = 598 * MiB;
constexpr size_t WS_DUMMY = 1144 * MiB;
constexpr size_t WS_G = 1670 * MiB;
constexpr size_t WS_CR = 982 * MiB, WS_CKVN = 1094 * MiB, WS_KR = 1110 * MiB, WS_CQN = 1112 * MiB, WS_KV = 1144 * MiB, WS_Q = 1400 * MiB;
constexpr size_t WS_O = 1670 * MiB;
constexpr size_t WS_END = 2014 * MiB;
constexpr int CW_TMO = 0, CW_CODE = 1, CW_BAR = 4096;
constexpr int RING_OFF = 0, RING_BYTES = 131072;
constexpr int LDS_BYTES = 147456;
constexpr int LDSCTL_OFF = LDS_BYTES - 512, MISC_OFF = LDSCTL_OFF + 320;
static_assert(MISC_OFF + 128 <= LDS_BYTES && mla::LDS_BYTES <= LDSCTL_OFF && RING_BYTES <= LDSCTL_OFF, "LDS map");
constexpr int RSL_OFF = 133120, RSL_ROWS = 2048;
static_assert(RSL_OFF >= RING_BYTES && RSL_OFF + RSL_ROWS * 4 <= LDSCTL_OFF, "LDS map: row-scale table");

#define GAS __attribute__((address_space(1)))
#define LAS __attribute__((address_space(3)))
typedef unsigned short bf16;
typedef unsigned v4u __attribute__((ext_vector_type(4)));
typedef unsigned v2u __attribute__((ext_vector_type(2)));
typedef float f32x4 __attribute__((ext_vector_type(4)));
typedef float f32x2 __attribute__((ext_vector_type(2)));
typedef GAS unsigned gu32;
#define RLX_AGENT __ATOMIC_RELAXED, __HIP_MEMORY_SCOPE_AGENT
#define LDS_WAIT() asm volatile("s_waitcnt lgkmcnt(0)" ::: "memory")
#define VM_WAIT() asm volatile("s_waitcnt vmcnt(0)" ::: "memory")
__device__ __forceinline__ unsigned f2bf(float f) { unsigned u = __builtin_bit_cast(unsigned, f); return (u + 0x7fffu + ((u >> 16) & 1u)) >> 16; }
__device__ __forceinline__ unsigned pk2(float lo, float hi) { return f2bf(lo) | (f2bf(hi) << 16); }
__device__ __forceinline__ float bflo(unsigned w) { return __builtin_bit_cast(float, w << 16); }
__device__ __forceinline__ float bfhi(unsigned w) { return __builtin_bit_cast(float, w & 0xffff0000u); }

#define XB_TMO      128
#define XB_XCNT(j)  (256  + 64 * (j))
#define XB_XSUB(j)  (1280 + 64 * (j))
#define XB_XGEN(j)  (2304 + 64 * (j))
#define XB_TOP      3328
#define XB_TOPGEN   3392
#define XCD_BAR_WORDS 3456
#define XB_SPIN_CAP (1u << 18)

__device__ __forceinline__ unsigned xb_ld(unsigned* p)              { return __hip_atomic_load(p, __ATOMIC_RELAXED, __HIP_MEMORY_SCOPE_AGENT); }
__device__ __forceinline__ unsigned xb_add(unsigned* p, unsigned v) { return __hip_atomic_fetch_add(p, v, __ATOMIC_RELAXED, __HIP_MEMORY_SCOPE_AGENT); }
__device__ __forceinline__ unsigned xb_xcc_id() { return (unsigned)__builtin_amdgcn_s_getreg((3 << 11) | 20) & 0xFu; }
#define XB_SPIN(cond, bar) do { unsigned _sp = 0; while (cond) { __builtin_amdgcn_s_sleep(1); \
    if ((++_sp & 255u) == 0u) { if (xb_ld(&(bar)[XB_TMO])) break; if (_sp > XB_SPIN_CAP) { atomicAdd(&(bar)[XB_TMO], 1u); break; } } } } while (0)

struct XcdBarrier {
    unsigned* bar; unsigned x;
    volatile LAS unsigned* st;
};

__device__ __forceinline__ XcdBarrier xcd_barrier_post(unsigned* bar, volatile LAS unsigned* st, const bool leader  ) {
    XcdBarrier b; b.bar = bar; b.x = xb_xcc_id(); b.st = st;
    if (leader) (void)xb_add(&bar[XB_XCNT(b.x)], 1u);
    return b;
}
__device__ __forceinline__ void xcd_barrier_complete(unsigned* bar, unsigned x, unsigned& nloc, unsigned& nx) {
    const unsigned G = gridDim.x * gridDim.y * gridDim.z;
    unsigned sum, cnt, mine, sp = 0u;
    for (;;) {
        sum = 0u; cnt = 0u; mine = 0u;
#pragma unroll
        for (unsigned j = 0; j < 16; ++j) { const unsigned c = xb_ld(&bar[XB_XCNT(j)]); sum += c; cnt += (c > 0u) ? 1u : 0u; mine = (j == x) ? c : mine; }
        if (sum == G) break;
        __builtin_amdgcn_s_sleep(1);
        if ((++sp & 255u) == 0u) { if (xb_ld(&bar[XB_TMO])) break; if (sp > XB_SPIN_CAP) { atomicAdd(&bar[XB_TMO], 1u); break; } }
    }
    nloc = mine > 0u ? mine : 1u; nx = cnt > 0u ? cnt : 1u;
}

__device__ __forceinline__ void xcd_barrier(const XcdBarrier& b, const bool leader  ) {
    asm volatile("s_waitcnt vmcnt(0)" ::: "memory");
    __syncthreads();
    if (leader) {
        unsigned* bar = b.bar;
        __builtin_amdgcn_s_waitcnt(0);
        unsigned nloc = b.st[0], nx = b.st[1];
        if (nloc == 0u) { xcd_barrier_complete(bar, b.x, nloc, nx); b.st[0] = nloc; b.st[1] = nx; }
        const unsigned old = xb_add(&bar[XB_XSUB(b.x)], 1u);
        const unsigned gen = old / nloc;
        if (old + 1u == (gen + 1u) * nloc) {
            __builtin_amdgcn_fence(__ATOMIC_RELEASE, "agent");
            asm volatile("s_waitcnt vmcnt(0)" ::: "memory");
            const unsigned og = xb_add(&bar[XB_TOP], 1u);
            const unsigned tg = og / nx;
            if (og + 1u == (tg + 1u) * nx) xb_add(&bar[XB_TOPGEN], 1u);
            else XB_SPIN(xb_ld(&bar[XB_TOPGEN]) == tg, bar);
            __builtin_amdgcn_fence(__ATOMIC_ACQUIRE, "agent");
            xb_add(&bar[XB_XGEN(b.x)], 1u);
            asm volatile("s_waitcnt vmcnt(0)" ::: "memory");
        } else {
            XB_SPIN(xb_ld(&bar[XB_XGEN(b.x)]) == gen, bar);
            __builtin_amdgcn_fence(__ATOMIC_ACQUIRE, "agent");
            asm volatile("s_waitcnt vmcnt(0)" ::: "memory");
        }
    }
    __syncthreads();
}


struct Frame {
    LAS unsigned char* lds; volatile LAS unsigned* MISC; gu32* ctl;
    int wave, vcu, G;
    const float* in[19]; float* out; unsigned char* ws;
};
__device__ __forceinline__ float wave_sum(float v, int lane) {
#pragma unroll
    for (int o = 1; o < 64; o <<= 1) v += shfl_xor_f(v, o, lane);
    return v;
}
struct P0Item { const GAS float* src; size_t st8; const GAS float* gp; bf16* dst; int K; };
__device__ __forceinline__ P0Item p0_decode(Frame& F, int it, int lane) {
    constexpr int I_POOL = 16 * 32, I_DKV = 64 * 18, I_DQ = 64 * 32, I_UKV = 8 * 256, I_UQ = 16 * 192, I_WO = 64 * 128, I_WIN = 64 * 688, I_WOUT = 172 * 128;
    unsigned char* ws = F.ws; int r = it; const float* W; const float* gain = nullptr; bf16* WT; int K, N, row_off = 0; bool perm_win = false;
    if (r < 4 * I_POOL) { const int g = r / I_POOL; r -= g * I_POOL; W = F.in[2] + (size_t)g * 1024 * 1024; K = 1024; N = 1024; WT = (bf16*)(ws + WS_WPOOL); row_off = g * 1024; }
    else if ((r -= 4 * I_POOL) < I_DKV) { W = F.in[5]; K = DM; N = 576; WT = (bf16*)(ws + WS_WDKVQ); gain = F.in[4]; }
    else if ((r -= I_DKV) < I_DQ) { W = F.in[9]; K = DM; N = 1024; WT = (bf16*)(ws + WS_WDKVQ); row_off = 576; gain = F.in[8]; }
    else if ((r -= I_DQ) < I_UKV) { W = F.in[7]; K = 512; N = 8192; WT = (bf16*)(ws + WS_WUKV); gain = F.in[6]; }
    else if ((r -= I_UKV) < I_UQ) { W = F.in[11]; K = 1024; N = 6144; WT = (bf16*)(ws + WS_WUQ); gain = F.in[10]; }
    else if ((r -= I_UQ) < I_WO) { W = F.in[12]; K = DM; N = DM; WT = (bf16*)(ws + WS_WO); }
    else if ((r -= I_WO) < 2 * I_WIN) { const int l = r / I_WIN; r -= l * I_WIN; W = F.in[14] + (size_t)l * DM * NFF; K = DM; N = NFF; WT = (bf16*)(ws + WS_WIN + l * WIN_L); gain = F.in[13] + l * DM; perm_win = true; }
    else { r -= 2 * I_WIN; const int l = r / I_WOUT; r -= l * I_WOUT; W = F.in[17] + (size_t)l * DFF * DM; K = DFF; N = DM; WT = (bf16*)(ws + WS_WOUT + l * WOUT_L); }
    const int nblk = N / 32, kb = r / nblk, nb = r - kb * nblk, k0 = 64 * kb, n0 = 32 * nb, kq = lane >> 3, n4 = (lane & 7) * 4;
    P0Item D; D.src = (const GAS float*)W + (size_t)(k0 + kq) * N + n0 + n4; D.st8 = (size_t)8 * N; D.gp = gain ? (const GAS float*)gain + k0 + kq : nullptr;
    int drow = row_off + n0;
    if (perm_win) { const int half = n0 >= DFF ? 1 : 0, s = n0 - half * DFF; drow = (s >> 7) * 256 + half * 128 + (s & 127); }
    D.dst = WT + (size_t)drow * K + k0; D.K = K; return D;
}
#define P0_DECL(p) f32x4 p##0, p##1, p##2, p##3, p##4, p##5, p##6, p##7; float p##g0, p##g1, p##g2, p##g3, p##g4, p##g5, p##g6, p##g7
#define P0_LOAD(D, p) do { p##0 = *(const GAS f32x4*)((D).src); p##1 = *(const GAS f32x4*)((D).src + (D).st8); p##2 = *(const GAS f32x4*)((D).src + 2 * (D).st8); p##3 = *(const GAS f32x4*)((D).src + 3 * (D).st8); \
        p##4 = *(const GAS f32x4*)((D).src + 4 * (D).st8); p##5 = *(const GAS f32x4*)((D).src + 5 * (D).st8); p##6 = *(const GAS f32x4*)((D).src + 6 * (D).st8); p##7 = *(const GAS f32x4*)((D).src + 7 * (D).st8); \
        p##g0 = p##g1 = p##g2 = p##g3 = p##g4 = p##g5 = p##g6 = p##g7 = 1.f; \
        if ((D).gp) { p##g0 = (D).gp[0]; p##g1 = (D).gp[8]; p##g2 = (D).gp[16]; p##g3 = (D).gp[24]; p##g4 = (D).gp[32]; p##g5 = (D).gp[40]; p##g6 = (D).gp[48]; p##g7 = (D).gp[56]; } } while (0)
#define P0_COPY(d, s) do { d##0 = s##0; d##1 = s##1; d##2 = s##2; d##3 = s##3; d##4 = s##4; d##5 = s##5; d##6 = s##6; d##7 = s##7; \
        d##g0 = s##g0; d##g1 = s##g1; d##g2 = s##g2; d##g3 = s##g3; d##g4 = s##g4; d##g5 = s##g5; d##g6 = s##g6; d##g7 = s##g7; } while (0)
#define P0_PUT(i, v, g) do { d_[(8 * (i)) * 33 + 0] = v.x * g; d_[(8 * (i)) * 33 + 1] = v.y * g; d_[(8 * (i)) * 33 + 2] = v.z * g; d_[(8 * (i)) * 33 + 3] = v.w * g; } while (0)
#define P0_FINISH(D, p) do { LAS float* d_ = scr + (llane >> 3) * 33 + (llane & 7) * 4; \
        P0_PUT(0, p##0, p##g0); P0_PUT(1, p##1, p##g1); P0_PUT(2, p##2, p##g2); P0_PUT(3, p##3, p##g3); P0_PUT(4, p##4, p##g4); P0_PUT(5, p##5, p##g5); P0_PUT(6, p##6, p##g6); P0_PUT(7, p##7, p##g7); \
        LDS_WAIT(); asm volatile("" ::: "memory"); const int c_ = llane & 7; \
        _Pragma("unroll") for (int j_ = 0; j_ < 4; ++j_) { const int n_ = (llane >> 3) + 8 * j_; const LAS float* s_ = scr + (8 * c_) * 33 + n_; \
            v4u o_; o_.x = pk2(s_[0 * 33], s_[1 * 33]); o_.y = pk2(s_[2 * 33], s_[3 * 33]); o_.z = pk2(s_[4 * 33], s_[5 * 33]); o_.w = pk2(s_[6 * 33], s_[7 * 33]); \
            *(GAS v4u*)((D).dst + (size_t)n_ * (D).K + 8 * c_) = o_; } \
        LDS_WAIT(); asm volatile("" ::: "memory"); } while (0)
__device__ __forceinline__ void p0_prologue(Frame& F) {
    int lane_l = lane_id(), vcu_l = F.vcu; asm volatile("" : "+v"(lane_l)); asm volatile("" : "+s"(vcu_l)); int wave_l = F.wave; asm volatile("" : "+s"(wave_l)); const int llane = lane_l, lwave = wave_l, ltid = lwave * 64 + llane, lvcu = vcu_l;
    LAS float* scr = (LAS float*)(F.lds + RING_OFF + lwave * 16384);
    const int gw = lvcu * NWAVES + lwave, NGW = F.G * NWAVES;
    unsigned char* ws = F.ws;
    constexpr int NITEMS = 4 * (16 * 32) + 64 * 18 + 64 * 32 + 8 * 256 + 16 * 192 + 64 * 128 + 2 * (64 * 688) + 2 * (172 * 128);
    if (gw < NITEMS) {
        int it = gw; P0Item A = p0_decode(F, it, llane); P0_DECL(a); P0_DECL(b); P0_LOAD(A, a);
        for (;;) { const int nx = it + NGW; const bool more = nx < NITEMS; P0Item B = A; P0_COPY(b, a);
            if (more) { B = p0_decode(F, nx, llane); P0_LOAD(B, b); }
            P0_FINISH(A, a);
            if (!more) break;
            A = B; P0_COPY(a, b); it = nx; }
    }
    const int gt = lvcu * (NWAVES * 64) + ltid, NT = F.G * NWAVES * 64;
    { GAS v4u* z = (GAS v4u*)(ws + WS_WDKVQ + (size_t)1600 * DM * 2); for (int i = gt; i < 192 * DM * 2 / 16; i += NT) z[i] = (v4u){0u, 0u, 0u, 0u}; }
    { GAS f32x2* T = (GAS f32x2*)(ws + WS_ROPE);
      for (int e = gt; e < S_ * 32; e += NT) { const int pos = e >> 5, i = e & 31;
          const float inv = __builtin_powf(10000.0f, -(float)(2 * i) / 64.0f); const float ang = (float)pos * inv;
          const double a = (double)ang, n = __builtin_rint(a * 0.15915494309189535), rd = __builtin_fma(-n, 6.283185307179586, a) - n * 2.4492935982947064e-16;
          const float r = (float)rd; T[e] = (f32x2){__builtin_cosf(r), __builtin_sinf(r)}; } }
}
#undef P0_DECL
#undef P0_LOAD
#undef P0_COPY
#undef P0_PUT
#undef P0_FINISH
constexpr int POOL_RUN = 32, POOL_HALO = 15;
__device__ __forceinline__ void pool_phase(Frame& F) {
    int lane_l = lane_id(), vcu_l = F.vcu; asm volatile("" : "+v"(lane_l)); asm volatile("" : "+s"(vcu_l)); int wave_l = F.wave; asm volatile("" : "+s"(wave_l)); const int llane = lane_l, lwave = wave_l, ltid = lwave * 64 + llane, lvcu = vcu_l;
    const GAS float* x = (const GAS float*)F.in[0]; const GAS float* gain = (const GAS float*)F.in[1];
    GAS v4u* XP = (GAS v4u*)(F.ws + WS_XPB); LAS float* rsl = (LAS float*)(F.lds + RSL_OFF);
    const int ch = ltid * 8, w = 2 << (ch >> 10);
    const f32x4 g0 = *(const GAS f32x4*)(gain + ch), g1 = *(const GAS f32x4*)(gain + ch + 4);
    for (int r = lvcu; r < S_ / POOL_RUN; r += F.G) { const int t0 = r * POOL_RUN, tb = t0 - POOL_HALO;
        for (int j = lwave; j < POOL_RUN + POOL_HALO; j += NWAVES) { const int t = tb + j; if (t < 0) continue;
            const GAS f32x4* xr = (const GAS f32x4*)(x + (size_t)t * DM) + llane; float s = 0.f;
#pragma unroll
            for (int q = 0; q < 16; ++q) { const f32x4 v = xr[64 * q]; s += (v.x * v.x + v.y * v.y) + (v.z * v.z + v.w * v.w); }
            const float tot = wave_sum(s, llane); if (llane == 0) rsl[j] = 1.0f / __builtin_sqrtf(tot * (1.f / DM) + EPS); }
        __syncthreads();
        f32x4 s0 = {0.f, 0.f, 0.f, 0.f}, s1 = s0;
        for (int q = (t0 - w + 1 > 0 ? t0 - w + 1 : 0); q < t0; ++q) { const float rq = rsl[q - tb]; const GAS f32x4* p = (const GAS f32x4*)(x + (size_t)q * DM + ch); s0 += p[0] * rq; s1 += p[1] * rq; }
#pragma unroll 4
        for (int t = t0; t < t0 + POOL_RUN; ++t) { const float rt = rsl[t - tb]; const GAS f32x4* p = (const GAS f32x4*)(x + (size_t)t * DM + ch); const f32x4 c0 = p[0] * rt, c1 = p[1] * rt;
            s0 += c0; s1 += c1;
            const int lo = t - w + 1; const float ic = 1.0f / (float)(lo > 0 ? w : t + 1);
            const f32x4 o0 = (s0 * ic - c0) * g0, o1 = (s1 * ic - c1) * g1;
            XP[(size_t)t * (DM / 8) + ltid] = (v4u){pk2(o0.x, o0.y), pk2(o0.z, o0.w), pk2(o1.x, o1.y), pk2(o1.z, o1.w)};
            if (lo >= 0) { const float rl = rsl[lo - tb]; const GAS f32x4* pl = (const GAS f32x4*)(x + (size_t)lo * DM + ch); s0 -= pl[0] * rl; s1 -= pl[1] * rl; } }
        __syncthreads();
    }
}
__device__ __forceinline__ void norm_phase(Frame& F, bool final_, const float* gain) {
    int lane_l = lane_id(), vcu_l = F.vcu; asm volatile("" : "+v"(lane_l)); asm volatile("" : "+s"(vcu_l)); int wave_l = F.wave; asm volatile("" : "+s"(wave_l)); const int llane = lane_l, lwave = wave_l, lvcu = vcu_l;
    (void)final_;
    const int gw = lvcu * NWAVES + lwave, NGW = F.G * NWAVES;
    const bf16* HB = (const bf16*)(F.ws + WS_XN);
    for (int m = gw; m < S_; m += NGW) { const GAS v4u* xr = (const GAS v4u*)(HB + (size_t)m * DM) + llane; v4u v[8]; float s = 0.f;
#pragma unroll
        for (int j = 0; j < 8; ++j) { v[j] = xr[64 * j]; const float a0 = bflo(v[j].x), a1 = bfhi(v[j].x), a2 = bflo(v[j].y), a3 = bfhi(v[j].y), a4 = bflo(v[j].z), a5 = bfhi(v[j].z), a6 = bflo(v[j].w), a7 = bfhi(v[j].w);
            s += (a0 * a0 + a1 * a1) + (a2 * a2 + a3 * a3) + (a4 * a4 + a5 * a5) + (a6 * a6 + a7 * a7); }
        const float rs = 1.0f / __builtin_sqrtf(wave_sum(s, llane) * (1.f / DM) + EPS);
        GAS f32x4* o = (GAS f32x4*)(F.out + (size_t)m * DM) + 2 * llane; const GAS f32x4* gp = (const GAS f32x4*)gain + 2 * llane;
#pragma unroll
        for (int j = 0; j < 8; ++j) { const f32x4 g0 = gp[128 * j], g1 = gp[128 * j + 1];
            o[128 * j] = (f32x4){bflo(v[j].x), bfhi(v[j].x), bflo(v[j].y), bfhi(v[j].y)} * rs * g0; o[128 * j + 1] = (f32x4){bflo(v[j].z), bfhi(v[j].z), bflo(v[j].w), bfhi(v[j].w)} * rs * g1; } }
}
__device__ __forceinline__ void rs_to_lds(Frame& F, int row_base) {
    int lane_l = lane_id(); asm volatile("" : "+v"(lane_l)); int wave_l = F.wave; asm volatile("" : "+s"(wave_l)); const int ltid = wave_l * 64 + lane_l;
    const GAS f32x4* SSQ = (const GAS f32x4*)(F.ws + WS_SSQ); LAS float* RSL = (LAS float*)(F.lds + RSL_OFF);
    for (int r = ltid; r < RSL_ROWS; r += NWAVES * 64) { const GAS f32x4* p = SSQ + (size_t)(row_base + r) * 16; float s = 0.f;
#pragma unroll
        for (int q = 0; q < 16; ++q) { const f32x4 v = p[q]; s += (v.x + v.y) + (v.z + v.w); }
        RSL[r] = 1.0f / __builtin_sqrtf(s * (1.f / DM) + EPS); }
    __syncthreads();
}
__device__ __forceinline__ void fixup_phase(Frame& F, int layer) {
    int lane_l = lane_id(), vcu_l = F.vcu; asm volatile("" : "+v"(lane_l)); asm volatile("" : "+s"(vcu_l)); int wave_l = F.wave; asm volatile("" : "+s"(wave_l)); const int llane = lane_l, lwave = wave_l, ltid = lwave * 64 + llane, lvcu = vcu_l;
    const int gt = lvcu * (NWAVES * 64) + ltid, NT = F.G * NWAVES * 64;
    constexpr int NCH = DFF / 8, NRUN = S_ / 64;
    const float* cw = F.in[15] + (size_t)layer * 3 * NFF; const float* cb = F.in[16] + (size_t)layer * NFF;
    const bf16* UE = (const bf16*)(F.ws + WS_UE); bf16* Gb = (bf16*)(F.ws + WS_G);
    for (int it = gt; it < (NRUN - 1) * NCH; it += NT) { const int r = 1 + it / NCH, c = it % NCH, j0 = c * 8;
        const bf16* ep = UE + ((size_t)(r - 1) * 4 + 2) * NFF + j0;
        float o0[8], o1[8];
#pragma unroll
        for (int h = 0; h < 2; ++h) {
            const v4u a = *(const GAS v4u*)(ep + h * DFF), b = *(const GAS v4u*)(ep + NFF + h * DFF), cc = *(const GAS v4u*)(ep + 2 * NFF + h * DFF), d = *(const GAS v4u*)(ep + 3 * NFF + h * DFF);
            const unsigned aw[4] = {a.x, a.y, a.z, a.w}, bw[4] = {b.x, b.y, b.z, b.w}, cw4[4] = {cc.x, cc.y, cc.z, cc.w}, dw[4] = {d.x, d.y, d.z, d.w};
#pragma unroll
            for (int e = 0; e < 8; ++e) { const float um2 = (e & 1) ? bfhi(aw[e >> 1]) : bflo(aw[e >> 1]), um1 = (e & 1) ? bfhi(bw[e >> 1]) : bflo(bw[e >> 1]), u0 = (e & 1) ? bfhi(cw4[e >> 1]) : bflo(cw4[e >> 1]), u1 = (e & 1) ? bfhi(dw[e >> 1]) : bflo(dw[e >> 1]);
                const int col = h * DFF + j0 + e; const float w0 = cw[col], w1 = cw[NFF + col], w2 = cw[2 * NFF + col], bb = cb[col];
                const float y0 = bb + w0 * um2 + w1 * um1 + w2 * u0, y1 = bb + w0 * um1 + w1 * u0 + w2 * u1;
                if (h == 0) { o0[e] = y0 * __builtin_amdgcn_rcpf(1.0f + __builtin_amdgcn_exp2f(-1.4426950408889634f * y0)); o1[e] = y1 * __builtin_amdgcn_rcpf(1.0f + __builtin_amdgcn_exp2f(-1.4426950408889634f * y1)); }
                else { o0[e] *= y0; o1[e] *= y1; } }
        }
        *(GAS v4u*)(Gb + (size_t)(64 * r) * DFF + j0) = (v4u){pk2(o0[0], o0[1]), pk2(o0[2], o0[3]), pk2(o0[4], o0[5]), pk2(o0[6], o0[7])};
        *(GAS v4u*)(Gb + (size_t)(64 * r + 1) * DFF + j0) = (v4u){pk2(o1[0], o1[1]), pk2(o1[2], o1[3]), pk2(o1[4], o1[5]), pk2(o1[6], o1[7])};
    }
}
__device__ __forceinline__ void latnorm_phase(Frame& F) {
    int lane_l = lane_id(), vcu_l = F.vcu; asm volatile("" : "+v"(lane_l)); asm volatile("" : "+s"(vcu_l)); int wave_l = F.wave; asm volatile("" : "+s"(wave_l)); const int llane = lane_l, lwave = wave_l, ltid = lwave * 64 + llane, lvcu = vcu_l;
    const int gw = lvcu * NWAVES + lwave, NGW = F.G * NWAVES, l = llane;
    const float* CR = (const float*)(F.ws + WS_CR); const GAS f32x2* T = (const GAS f32x2*)(F.ws + WS_ROPE);
    for (int m = gw; m < S_; m += NGW) { const float* row = CR + (size_t)m * NDKVQ;
        const f32x4 a0 = *(const GAS f32x4*)(row + 8 * l), a1 = *(const GAS f32x4*)(row + 8 * l + 4);
        const f32x4 q0 = *(const GAS f32x4*)(row + 576 + 16 * l), q1 = *(const GAS f32x4*)(row + 576 + 16 * l + 4), q2 = *(const GAS f32x4*)(row + 576 + 16 * l + 8), q3 = *(const GAS f32x4*)(row + 576 + 16 * l + 12);
        const float x1 = row[512 + (l & 31)], x2 = row[544 + (l & 31)]; const f32x2 cs = T[(size_t)m * 32 + (l & 31)];
        float sa = (a0.x * a0.x + a0.y * a0.y) + (a0.z * a0.z + a0.w * a0.w) + (a1.x * a1.x + a1.y * a1.y) + (a1.z * a1.z + a1.w * a1.w);
        float sq = (q0.x * q0.x + q0.y * q0.y) + (q0.z * q0.z + q0.w * q0.w) + (q1.x * q1.x + q1.y * q1.y) + (q1.z * q1.z + q1.w * q1.w)
                 + (q2.x * q2.x + q2.y * q2.y) + (q2.z * q2.z + q2.w * q2.w) + (q3.x * q3.x + q3.y * q3.y) + (q3.z * q3.z + q3.w * q3.w);
        const float ra = 1.0f / __builtin_sqrtf(wave_sum(sa, llane) * (1.f / 512.f) + EPS), rq = 1.0f / __builtin_sqrtf(wave_sum(sq, llane) * (1.f / 1024.f) + EPS);
        *(GAS v4u*)(F.ws + WS_CKVN + ((size_t)m * 512 + 8 * l) * 2) = (v4u){pk2(a0.x * ra, a0.y * ra), pk2(a0.z * ra, a0.w * ra), pk2(a1.x * ra, a1.y * ra), pk2(a1.z * ra, a1.w * ra)};
        GAS v4u* cq = (GAS v4u*)(F.ws + WS_CQN + ((size_t)m * 1024 + 16 * l) * 2);
        cq[0] = (v4u){pk2(q0.x * rq, q0.y * rq), pk2(q0.z * rq, q0.w * rq), pk2(q1.x * rq, q1.y * rq), pk2(q1.z * rq, q1.w * rq)};
        cq[1] = (v4u){pk2(q2.x * rq, q2.y * rq), pk2(q2.z * rq, q2.w * rq), pk2(q3.x * rq, q3.y * rq), pk2(q3.z * rq, q3.w * rq)};
        GAS bf16* kr = (GAS bf16*)(F.ws + WS_KR) + (size_t)m * 64;
        if (l < 32) kr[l] = (bf16)f2bf(x1 * cs.x - x2 * cs.y); else kr[l] = (bf16)f2bf(x2 * cs.x + x1 * cs.y); }
}
#ifndef PG8_SP2
#define PG8_SP2 true
#endif
#ifndef PG8_ALIGN
#define PG8_ALIGN true
#endif
#ifndef FFN2_WGM
#define FFN2_WGM 2
#endif
#ifndef PG8_ALIGN_RES
#define PG8_ALIGN_RES true
#endif
struct Args { const float* in[19]; float* out; unsigned char* ws; int ph_lo, ph_hi; };
__global__ void __launch_bounds__(NWAVES * 64, 2) mk_fwd(Args args) {
    extern __shared__ __attribute__((aligned(16))) unsigned char lds[];
    Frame F;
    F.lds = (LAS unsigned char*)lds;
    F.MISC = (volatile LAS unsigned*)(F.lds + MISC_OFF);
    F.wave = __builtin_amdgcn_readfirstlane((int)threadIdx.x >> 6);
    F.G = gridDim.x; { const int bx = blockIdx.x; F.vcu = (F.G % 8 == 0) ? (bx % 8) * (F.G / 8) + bx / 8 : bx; }
    F.ws = args.ws; F.out = args.out; F.ctl = (gu32*)(args.ws + WS_CTL);
#pragma unroll
    for (int i = 0; i < 19; ++i) F.in[i] = args.in[i];
    for (int u = (int)threadIdx.x; u < (LDS_BYTES - LDSCTL_OFF) / 4; u += NWAVES * 64) ((LAS unsigned*)(F.lds + LDSCTL_OFF))[u] = 0u;
    __syncthreads();
    XcdBarrier bar; bar.bar = (unsigned*)(F.ctl + CW_BAR); bar.x = 0; bar.st = nullptr;
    if (N_LAUNCHES == 1) bar = xcd_barrier_post((unsigned*)(F.ctl + CW_BAR), F.MISC + 8, threadIdx.x == 0);
    const int lo = args.ph_lo, hi = args.ph_hi; int pid = 0;
#define BIDX() ({ int b_ = (int)blockIdx.x; asm volatile("" : "+s"(b_)); b_; })
    unsigned char* ws = args.ws;
#define IN() (lo <= pid && pid < hi)
#define GBAR() xcd_barrier(bar, F.wave == 0 && lane_id() == 0)
#define SEAM() do { if (N_LAUNCHES == 1 && lo <= pid && pid + 1 < hi) GBAR(); ++pid; } while (0)
#ifndef REPEAT_SITES
#define REPEAT_SITES 0u
#endif
#define REPS(site) (((REPEAT_SITES >> (site)) & 1u) ? 2 : 1)
#define PH_BEGIN(site) if (IN()) { for (int rep_ = 0; rep_ < REPS(site); ++rep_) { if (rep_) GBAR(); const bool dry_ = (rep_ + 1 < REPS(site)); (void)dry_;
#define PH_END() } } SEAM();
    bf16* const Hdummy = (bf16*)(args.ws + WS_DUMMY);
    PH_BEGIN(0) { p0_prologue(F); __syncthreads(); pool_phase(F); } PH_END()
    for (int l = 0; l < 2; ++l) {
        if (l == 0) {
            PH_BEGIN(2) {
                pg8::Gemm g{(const bf16*)(ws + WS_XPB), (const bf16*)(ws + WS_WPOOL), S_, DM, 1024, DM}; pg8::PoolOrder S; S.init(S_, DM, F.G, BIDX());
                pg8::EpiResStat E{F.in[0], DM, F.in[3], (bf16*)(ws + WS_XN), (float*)(ws + WS_SSQ), (bf16*)(ws + WS_XN)};
                pg8::gemm_phase<pg8::EpiResStat, pg8::PoolOrder, PG8_ALIGN_RES, PG8_SP2>(F.lds + RING_OFF, g, S, E, F.wave);
            } PH_END()
        } else {
            PH_BEGIN(3) {
                pg8::Gemm g{(const bf16*)(ws + WS_XN), (const bf16*)(ws + WS_WDKVQ), S_, NDKVQ, DM, DM}; pg8::StaticOrder S; S.init(S_, NDKVQ, F.G, BIDX());
                const int cb_ = BIDX(), rb_ = 2048 * (cb_ & 7); rs_to_lds(F, rb_);
                pg8::EpiF32S E{(float*)(ws + WS_CR), NDKVQ, (const PG8_LAS float*)(F.lds + RSL_OFF), rb_};
                pg8::gemm_phase<pg8::EpiF32S, pg8::StaticOrder, PG8_ALIGN, PG8_SP2>(F.lds + RING_OFF, g, S, E, F.wave);
            } PH_END()
            PH_BEGIN(4) latnorm_phase(F); PH_END()
            PH_BEGIN(5) {
                { pg8::Gemm g{(const bf16*)(ws + WS_CKVN), (const bf16*)(ws + WS_WUKV), S_, 8192, 512, 512}; pg8::StaticOrder S; S.init(S_, 8192, F.G, BIDX());
                  pg8::EpiBf16 E{(bf16*)(ws + WS_KV), 8192};
                  pg8::gemm_phase<pg8::EpiBf16, pg8::StaticOrder, PG8_ALIGN, PG8_SP2>(F.lds + RING_OFF, g, S, E, F.wave); }
                { pg8::Gemm g{(const bf16*)(ws + WS_CQN), (const bf16*)(ws + WS_WUQ), S_, 6144, 1024, 1024}; pg8::StaticOrder S; S.init(S_, 6144, F.G, BIDX());
                  pg8::EpiBf16 E{(bf16*)(ws + WS_Q), 6144};
                  pg8::gemm_phase<pg8::EpiBf16, pg8::StaticOrder, PG8_ALIGN, PG8_SP2>(F.lds + RING_OFF, g, S, E, F.wave); }
            } PH_END()
            PH_BEGIN(7) { const mla::Tensors T{(const bf16*)(ws + WS_Q), (const bf16*)(ws + WS_KV), (const bf16*)(ws + WS_KR), (bf16*)(ws + WS_O), (const float*)(ws + WS_ROPE)};
                mla::attn_phase((char*)lds + RING_OFF, (mla::lds_uc*)(F.lds + RING_OFF), T, (int)F.G, BIDX(), F.wave); } PH_END()
            PH_BEGIN(8) {
                pg8::Gemm g{(const bf16*)(ws + WS_O), (const bf16*)(ws + WS_WO), S_, DM, DM, DM}; pg8::StaticOrder S; S.init(S_, DM, F.G, BIDX());
                pg8::EpiResStat E{nullptr, DM, nullptr, (bf16*)(ws + WS_XN), (float*)(ws + WS_SSQ), dry_ ? Hdummy : (bf16*)(ws + WS_XN)};
                pg8::gemm_phase<pg8::EpiResStat, pg8::StaticOrder, PG8_ALIGN_RES, PG8_SP2>(F.lds + RING_OFF, g, S, E, F.wave);
            } PH_END()
        }
        PH_BEGIN(10) {
            pg8::Gemm g{(const bf16*)(ws + WS_XN), (const bf16*)(ws + WS_WIN + l * WIN_L), S_, NFF, DM, DM}; pg8::StaticOrder S; S.init(S_, NFF, F.G, BIDX());
            const int cb_ = BIDX(), rb_ = 2048 * (cb_ & 7); rs_to_lds(F, rb_);
            pg8::EpiConvGate E{(bf16*)(ws + WS_G), (const PG8_LAS float*)(F.lds + RSL_OFF), rb_, F.in[15] + (size_t)l * 3 * NFF, F.in[16] + (size_t)l * NFF, (bf16*)(ws + WS_UE)};
            pg8::gemm_phase<pg8::EpiConvGate, pg8::StaticOrder, PG8_ALIGN, PG8_SP2>(F.lds + RING_OFF, g, S, E, F.wave);
        } PH_END()
        PH_BEGIN(11) fixup_phase(F, l); PH_END()
        PH_BEGIN(12) {
            pg8::Gemm g{(const bf16*)(ws + WS_G), (const bf16*)(ws + WS_WOUT + l * WOUT_L), S_, DM, DFF, DFF}; pg8::StaticOrder S; S.init(S_, DM, F.G, BIDX()); S.wgm = FFN2_WGM;
            pg8::EpiResStat E{nullptr, DM, nullptr, (bf16*)(ws + WS_XN), (float*)(ws + WS_SSQ), dry_ ? Hdummy : (bf16*)(ws + WS_XN)};
            pg8::gemm_phase<pg8::EpiResStat, pg8::StaticOrder, PG8_ALIGN_RES, PG8_SP2>(F.lds + RING_OFF, g, S, E, F.wave);
        } PH_END()
        if (l == 1) { PH_BEGIN(14) norm_phase(F, true, F.in[18]); PH_END() }
    }
#undef IN
#undef SEAM
#undef PH_BEGIN
#undef PH_END
}

#if defined(DEBUG_GOLD)
namespace dbg {
__device__ __forceinline__ float ldv(const float* p) { return *p; }
__device__ __forceinline__ float ldv(const unsigned short* p) { return __builtin_bit_cast(float, (unsigned)(*p) << 16); }
template <class T> __global__ void g_cmp(const T* fast, int ldf, const float* ref, int ldr, int rows, int cols, unsigned* status, unsigned code, float tol) {
    __shared__ double sd[16], sr[16]; __shared__ int bad;
    if (threadIdx.x == 0) bad = 0; __syncthreads();
    double d2 = 0.0, r2 = 0.0; int nb = 0;
    for (size_t i = threadIdx.x; i < (size_t)rows * cols; i += 1024) { const int r = (int)(i / cols), c = (int)(i % cols); const float f = ldv(fast + (size_t)r * ldf + c), g = ref[(size_t)r * ldr + c];
        if (!(f == f) || __builtin_fabsf(f) > 1e30f) nb = 1; const double d = (double)f - (double)g; d2 += d * d; r2 += (double)g * (double)g; }
    for (int o = 32; o >= 1; o >>= 1) { d2 += __shfl_xor(d2, o); r2 += __shfl_xor(r2, o); }
    if (nb) bad = 1;
    if ((threadIdx.x & 63) == 0) { sd[threadIdx.x >> 6] = d2; sr[threadIdx.x >> 6] = r2; } __syncthreads();
    if (threadIdx.x == 0) { double a = 0, b = 0; for (int i = 0; i < 16; ++i) { a += sd[i]; b += sr[i]; }
        if (bad || !(a <= (double)tol * b)) atomicCAS(status, 0u, code); }
}
__global__ void g_judge(const unsigned* status, float* out, size_t n) { const unsigned s = *status; if (s == 0u) return; const float v = sqrtf(10.f * (float)s);
    for (size_t i = (size_t)blockIdx.x * 256 + threadIdx.x; i < n; i += (size_t)gridDim.x * 256) out[i] = v; }
}
static void debug_forward(Args a, int grid, hipStream_t st) {
    using namespace gold;
    unsigned char* ws = a.ws; const float* const* in = a.in;
    Bufs b = carve(ws + (2048ull << 20));
    float* X2 = b.O + (size_t)GT0 * DM;
    unsigned* status = (unsigned*)(ws + WS_CTL) + 8;
    const float TOL = 3e-4f; unsigned code = 0; int p = 0;
    auto run = [&](int n) { for (int i = 0; i < n; ++i, ++p) { a.ph_lo = p; a.ph_hi = p + 1; hipLaunchKernelGGL(mk_fwd, dim3(grid), dim3(NWAVES * 64), LDS_BYTES, st, a); } };
    auto cmpf = [&](const void* f, int ldf, const float* r, int ldr, int cols) { ++code; dbg::g_cmp<float><<<1, 1024, 0, st>>>((const float*)f, ldf, r, ldr, GT0, cols, status, code, TOL); };
    auto cmpb = [&](const void* f, int ldf, const float* r, int ldr, int cols) { ++code; dbg::g_cmp<unsigned short><<<1, 1024, 0, st>>>((const unsigned short*)f, ldf, r, ldr, GT0, cols, status, code, TOL); };
    auto gffn = [&](int layer) {
        const float* fn = in[13] + (size_t)layer * DM; const float* win = in[14] + (size_t)layer * DM * NFF; const float* cw = in[15] + (size_t)layer * 3 * NFF;
        const float* cb = in[16] + (size_t)layer * NFF; const float* wout = in[17] + (size_t)layer * DFF * DM;
        cmpb(ws + WS_XN, DM, b.H, DM, DM);
        g_rmsnorm<<<GT0, 256, 0, st>>>(b.H, DM, fn, b.XN, DM, DM);
        g_matmul<0><<<dim3(NFF / 256, GT0 / 8), 256, 0, st>>>(b.XN, DM, win, NFF, b.U, NFF, DM, NFF, nullptr, 0, nullptr);
        g_convgate<<<GT0, 256, 0, st>>>(b.U, cw, cb, b.G);
        run(1); run(1); cmpb(ws + WS_G, DFF, b.G, DFF, DFF);
        g_matmul<1><<<dim3(DM / 256, GT0 / 8), 256, 0, st>>>(b.G, DFF, wout, DM, b.H, DM, DFF, DM, nullptr, 0, nullptr);
        run(1); cmpb(ws + WS_XN, DM, b.H, DM, DM);
    };
    const float* x = in[0];
    g_rmsnorm<<<GT0, 256, 0, st>>>(x, DM, in[1], b.XN, DM, DM); g_pool<<<GT0, 256, 0, st>>>(b.XN, b.T1);
    run(1); cmpb(ws + WS_XPB, DM, b.T1, DM, DM);
    for (int g = 0; g < 4; ++g)
        g_matmul<2><<<dim3(1024 / 256, GT0 / 8), 256, 0, st>>>(b.T1 + g * 1024, DM, in[2] + (size_t)g * 1024 * 1024, 1024, b.H + g * 1024, DM, 1024, 1024, x + g * 1024, DM, in[3] + g * 1024);
    run(1); cmpb(ws + WS_XN, DM, b.H, DM, DM);
    gffn(0);
    g_rmsnorm<<<GT0, 256, 0, st>>>(b.H, DM, in[4], b.XN, DM, DM);
    g_matmul<0><<<dim3(3, GT0 / 8), 256, 0, st>>>(b.XN, DM, in[5], 576, b.CKV, 576, DM, 576, nullptr, 0, nullptr);
    g_rmsnorm<<<GT0, 256, 0, st>>>(b.H, DM, in[8], b.XN, DM, DM);
    g_matmul<0><<<dim3(1024 / 256, GT0 / 8), 256, 0, st>>>(b.XN, DM, in[9], 1024, b.CQ, 1024, DM, 1024, nullptr, 0, nullptr);
    run(1); cmpf(ws + WS_CR, NDKVQ, b.CKV, 576, 576);
    cmpf(ws + WS_CR + 576 * 4, NDKVQ, b.CQ, 1024, 1024);
    g_rmsnorm<<<GT0, 256, 0, st>>>(b.CKV, 576, nullptr, X2, 512, 512);
    run(1); cmpb(ws + WS_CKVN, 512, X2, 512, 512);
    g_rmsnorm<<<GT0, 256, 0, st>>>(b.CQ, 1024, nullptr, X2, 1024, 1024); cmpb(ws + WS_CQN, 1024, X2, 1024, 1024);
    g_rmsnorm<<<GT0, 256, 0, st>>>(b.CKV, 576, in[6], b.CKVN, 512, 512);
    g_rope<<<GT0, 256, 0, st>>>(b.CKV, 576, 512, 0, 1); cmpb(ws + WS_KR, 64, b.CKV + 512, 576, 64);
    g_matmul<0><<<dim3(8192 / 256, GT0 / 8), 256, 0, st>>>(b.CKVN, 512, in[7], 8192, b.KVb, 8192, 512, 8192, nullptr, 0, nullptr);
    g_rmsnorm<<<GT0, 256, 0, st>>>(b.CQ, 1024, in[10], b.CQN, 1024, 1024);
    g_matmul<0><<<dim3(6144 / 256, GT0 / 8), 256, 0, st>>>(b.CQN, 1024, in[11], 6144, b.Q, 6144, 1024, 6144, nullptr, 0, nullptr);
    run(1); cmpb(ws + WS_KV, 8192, b.KVb, 8192, 8192);
    cmpb(ws + WS_Q, 6144, b.Q, 6144, 6144);
    g_rope<<<GT0, 256, 0, st>>>(b.Q, 6144, 128, 192, 32);
    g_attn<<<dim3(GT0, 32), 256, 0, st>>>(b.Q, b.KVb, b.CKV + 512, 576, b.O);
    run(1); cmpb(ws + WS_O, DM, b.O, DM, DM);
    g_matmul<1><<<dim3(DM / 256, GT0 / 8), 256, 0, st>>>(b.O, DM, in[12], DM, b.H, DM, DM, DM, nullptr, 0, nullptr);
    run(1); cmpb(ws + WS_XN, DM, b.H, DM, DM);
    gffn(1);
    run(1);
    g_rmsnorm<<<GT0, 256, 0, st>>>(b.H, DM, in[18], X2, DM, DM); cmpf(a.out, DM, X2, DM, DM);
    dbg::g_judge<<<1024, 256, 0, st>>>(status, a.out, (size_t)S_ * DM);
}
#endif
extern "C" void kernel_launch(void* const* d_in, const int* in_sizes, int n_in, void* d_out, int out_size, void* d_ws, size_t ws_size, hipStream_t stream) {
    static int grid = 0;
    if (grid == 0) {
        if (n_in != 19 || in_sizes[0] != S_ * DM || out_size != S_ * DM || ws_size < WS_END) { fprintf(stderr, "kernel_launch: unexpected shapes (n_in %d, in0 %d, out %d, ws %zu)\n", n_in, n_in > 0 ? in_sizes[0] : -1, out_size, ws_size); grid = -1; return; }
        int dev = 0, cus = 0, per_cu = 0;
        if (hipGetDevice(&dev) != hipSuccess || hipDeviceGetAttribute(&cus, hipDeviceAttributeMultiprocessorCount, dev) != hipSuccess) { grid = -1; return; }
        if (hipFuncSetAttribute((const void*)mk_fwd, hipFuncAttributeMaxDynamicSharedMemorySize, LDS_BYTES) != hipSuccess) { fprintf(stderr, "kernel_launch: hipFuncSetAttribute failed\n"); grid = -1; return; }
        if (hipOccupancyMaxActiveBlocksPerMultiprocessor(&per_cu, (const void*)mk_fwd, NWAVES * 64, LDS_BYTES) != hipSuccess || per_cu < 1) { fprintf(stderr, "kernel_launch: occupancy query says %d\n", per_cu); }
        (void)hipGetLastError();
        grid = cus;
        if (grid % 8 != 0) { fprintf(stderr, "kernel_launch: %d CUs: the per-workgroup row-scale tables assume a grid that is a multiple of 8\n", grid); grid = -1; return; }
    }
    if (grid < 0) return;
    (void)hipMemsetAsync((char*)d_ws + WS_CTL, 0, CTL_ZERO_BYTES, stream);
    Args a{};
    for (int i = 0; i < 19; ++i) a.in[i] = (const float*)d_in[i];
    a.out = (float*)d_out; a.ws = (unsigned char*)d_ws;
#if defined(DEBUG_GOLD)
    debug_forward(a, grid, stream);
#else
    if (N_LAUNCHES == 1) { a.ph_lo = 0; a.ph_hi = NPH; hipLaunchKernelGGL(mk_fwd, dim3(grid), dim3(NWAVES * 64), LDS_BYTES, stream, a); }
    else for (int p = 0; p < NPH; ++p) { a.ph_lo = p; a.ph_hi = p + 1; hipLaunchKernelGGL(mk_fwd, dim3(grid), dim3(NWAVES * 64), LDS_BYTES, stream, a); }
#endif
}
```

```cpp
#define MK_N_LAUNCHES 1
#define PG8_ALIGN_RES false
#include <hip/hip_runtime.h>
#include <cstdio>
#include <cstdint>
__device__ __forceinline__ int lane_id() { int l; asm volatile("v_mbcnt_lo_u32_b32 %0, -1, 0\n\tv_mbcnt_hi_u32_b32 %0, -1, %0" : "=v"(l)); return l; }
__device__ __forceinline__ float shfl_xor_f(float v, int m, int lane) { return __builtin_bit_cast(float, __builtin_amdgcn_ds_bpermute((lane ^ m) << 2, __builtin_bit_cast(int, v))); }
namespace pg8 {
#define PG8_LAS __attribute__((address_space(3)))
typedef unsigned short bf16_t;
typedef short bf16x8 __attribute__((ext_vector_type(8)));
typedef float f32x4 __attribute__((ext_vector_type(4)));
typedef unsigned u32x4 __attribute__((ext_vector_type(4)));
constexpr int BM = 256, BK = 64, HALF = 128, HTB = HALF * BK * 2  , STAGE_BYTES = 8 * HTB, NXCD = 8, WGM = 8;

__host__ __device__ __forceinline__ int lds_byte(int r, int c) { const int st = (r >> 4) * 2 + (c >> 5), rr = r & 15, cc = c & 31, ob = rr * 64 + cc * 2; return st * 1024 + (ob ^ (((ob >> 9) & 1) << 5)); }
__host__ __device__ __forceinline__ void stage_rc(int b, int& R, int& C) { const int st = b / 1024, sb = b % 1024, swz = sb ^ (((sb >> 9) & 1) << 5); R = (st >> 1) * 16 + swz / 64; C = (st & 1) * 32 + (swz % 64) / 2; }
__host__ __device__ __forceinline__ int perm32(int rho) { const int n = rho >> 4, i = rho & 15; return 8 * (i >> 2) + 4 * n + (i & 3); }

struct Unit { int pm, pn; };
struct Gemm { const bf16_t* A; const bf16_t* Bt; int M, N, K, lda; };

struct StaticOrder {
    int nM, nN, nwg, G, c, wgm = WGM, lim = 0x7fffffff;
    __host__ __device__ void init(int M, int N, int G_, int c_) { nM = M / BM; nN = N / BM; nwg = nM * nN; G = G_; c = c_; }
    __host__ __device__ bool next(int i, Unit& u) const {
        const long L = (long)i * G + c; if (L >= nwg || L >= lim) return false;
        int wgid = (int)L; { const int q = nwg / NXCD, r = nwg % NXCD, xcd = wgid % NXCD, off = wgid / NXCD; wgid = (xcd < r ? xcd * (q + 1) : r * (q + 1) + (xcd - r) * q) + off; }
        const int nig = wgm * nN, gid = wgid / nig, fm = gid * wgm, gsz = (nM - fm) < wgm ? (nM - fm) : wgm;
        u.pm = fm + ((wgid % nig) % gsz); u.pn = (wgid % nig) / gsz; return true;
    }
    __device__ __forceinline__ void a_ready(const Unit&) const {}
    __device__ __forceinline__ int acol(const Unit&) const { return 0; }
    __device__ __forceinline__ void done(const Unit&) const {}
};
__device__ __forceinline__ unsigned cvt_pk_bf16(float lo, float hi) { unsigned r; asm volatile("v_cvt_pk_bf16_f32 %0, %1, %2" : "=v"(r) : "v"(lo), "v"(hi)); return r; }
typedef float f32x2 __attribute__((ext_vector_type(2)));
struct PoolOrder : StaticOrder {
    __device__ __forceinline__ int acol(const Unit& u) const { return (u.pn >> 2) * 1024; }
};
struct TailOrder : StaticOrder {
    __device__ __forceinline__ bool next(int i, Unit& u) const { if (i != 0) return false; const int full = nwg / G, rem = nwg - full * G; StaticOrder T = *this; T.c = c % rem; T.lim = 0x7fffffff; return T.next(full, u); }
};
struct EpiResF32 {
    static constexpr bool PERM = false, AFTER_DRAIN = false;
    float* C; const float* R; int ldc; const float* scale;
    __device__ __forceinline__ void operator()(const f32x4 (&acc)[2][2][4][2], const Unit& u, int wr, int wc, int fr, int fq) const {
        const int row0 = u.pm * BM + wr * 64 + fr, col0 = u.pn * BM + wc * 32 + 4 * fq;
        f32x4 sv[2][2];
#pragma unroll
        for (int bj = 0; bj < 2; ++bj)
#pragma unroll
            for (int n = 0; n < 2; ++n) sv[bj][n] = scale ? *(const f32x4*)(scale + col0 + bj * HALF + n * 16) : (f32x4){1.f, 1.f, 1.f, 1.f};
#pragma unroll
        for (int ai = 0; ai < 2; ++ai)
#pragma unroll
            for (int m = 0; m < 4; ++m) { const size_t ro = (size_t)(row0 + ai * HALF + m * 16) * ldc + col0; const float* rp = R + ro; float* cp = C + ro;
                f32x4 rv[2][2];
#pragma unroll
                for (int bj = 0; bj < 2; ++bj)
#pragma unroll
                    for (int n = 0; n < 2; ++n) rv[bj][n] = *(const f32x4*)(rp + bj * HALF + n * 16);
#pragma unroll
                for (int bj = 0; bj < 2; ++bj)
#pragma unroll
                    for (int n = 0; n < 2; ++n) *(f32x4*)(cp + bj * HALF + n * 16) = rv[bj][n] + acc[ai][bj][m][n] * sv[bj][n]; }
    }
};
struct EpiF32 {
    static constexpr bool PERM = false, AFTER_DRAIN = false;
    float* C; int ldc;
    __device__ __forceinline__ void operator()(const f32x4 (&acc)[2][2][4][2], const Unit& u, int wr, int wc, int fr, int fq) const {
        const int row0 = u.pm * BM + wr * 64 + fr, col0 = u.pn * BM + wc * 32 + 4 * fq;
#pragma unroll
        for (int ai = 0; ai < 2; ++ai)
#pragma unroll
            for (int m = 0; m < 4; ++m) { float* rowp = C + (size_t)(row0 + ai * HALF + m * 16) * ldc + col0;
#pragma unroll
                for (int bj = 0; bj < 2; ++bj)
#pragma unroll
                    for (int n = 0; n < 2; ++n) *(f32x4*)(rowp + bj * HALF + n * 16) = acc[ai][bj][m][n]; }
    }
};
struct EpiBf16 {
    static constexpr bool PERM = true, AFTER_DRAIN = false;
    bf16_t* O; int ldc;
    __device__ __forceinline__ void operator()(const f32x4 (&acc)[2][2][4][2], const Unit& u, int wr, int wc, int fr, int fq) const {
        const int row0 = u.pm * BM + wr * 64 + fr, col0 = u.pn * BM + wc * 32 + 8 * fq;
#pragma unroll
        for (int ai = 0; ai < 2; ++ai)
#pragma unroll
            for (int m = 0; m < 4; ++m) { bf16_t* rowp = O + (size_t)(row0 + ai * HALF + m * 16) * ldc + col0;
#pragma unroll
                for (int bj = 0; bj < 2; ++bj) { const f32x4 v0 = acc[ai][bj][m][0], v1 = acc[ai][bj][m][1];
                    u32x4 w; w.x = cvt_pk_bf16(v0[0], v0[1]); w.y = cvt_pk_bf16(v0[2], v0[3]); w.z = cvt_pk_bf16(v1[0], v1[1]); w.w = cvt_pk_bf16(v1[2], v1[3]);
                    *(u32x4*)(rowp + bj * HALF) = w; } }
    }
};
__device__ __forceinline__ float dpp_ror1(float v) { return __builtin_bit_cast(float, __builtin_amdgcn_update_dpp(0, __builtin_bit_cast(int, v), 0x121, 0xf, 0xf, true)); }
__device__ __forceinline__ float dpp_shr1_old(float old, float v) { return __builtin_bit_cast(float, __builtin_amdgcn_update_dpp(__builtin_bit_cast(int, old), __builtin_bit_cast(int, v), 0x111, 0xf, 0xf, false)); }
__device__ __forceinline__ float dpp_shr2_old(float old, float v) { return __builtin_bit_cast(float, __builtin_amdgcn_update_dpp(__builtin_bit_cast(int, old), __builtin_bit_cast(int, v), 0x112, 0xf, 0xf, false)); }
__device__ __forceinline__ float dpp_ror2(float v) { return __builtin_bit_cast(float, __builtin_amdgcn_update_dpp(0, __builtin_bit_cast(int, v), 0x122, 0xf, 0xf, true)); }
struct EpiResStat {
    static constexpr bool PERM = true, AFTER_DRAIN = false;
    const float* Rf; int ldc; const float* scale; bf16_t* HB; float* SSQ; bf16_t* HBout;
    __device__ __forceinline__ void operator()(const f32x4 (&acc)[2][2][4][2], const Unit& u, int wr, int wc, int fr, int fq) const {
        const int row0 = u.pm * BM + wr * 64 + fr, col0 = u.pn * BM + wc * 32 + 8 * fq, lane = fq * 16 + fr;
        if (Rf) {
        f32x4 sv[2][2];
#pragma unroll
        for (int bj = 0; bj < 2; ++bj)
#pragma unroll
            for (int n = 0; n < 2; ++n) sv[bj][n] = scale ? *(const f32x4*)(scale + col0 + bj * HALF + 4 * n) : (f32x4){1.f, 1.f, 1.f, 1.f};
#pragma unroll
        for (int ai = 0; ai < 2; ++ai)
#pragma unroll
            for (int m = 0; m < 4; ++m) { const int row = row0 + ai * HALF + m * 16; const size_t ro = (size_t)row * ldc + col0;
                f32x4 rv[2][2]; float ss = 0.f;
#pragma unroll
                for (int bj = 0; bj < 2; ++bj)
#pragma unroll
                    for (int n = 0; n < 2; ++n) rv[bj][n] = *(const f32x4*)(Rf + ro + bj * HALF + 4 * n);
#pragma unroll
                for (int bj = 0; bj < 2; ++bj) { const f32x4 h0 = rv[bj][0] + acc[ai][bj][m][0] * sv[bj][0], h1 = rv[bj][1] + acc[ai][bj][m][1] * sv[bj][1];
                    u32x4 w; w.x = cvt_pk_bf16(h0[0], h0[1]); w.y = cvt_pk_bf16(h0[2], h0[3]); w.z = cvt_pk_bf16(h1[0], h1[1]); w.w = cvt_pk_bf16(h1[2], h1[3]);
                    *(u32x4*)(HBout + ro + bj * HALF) = w;
                    ss += (h0[0] * h0[0] + h0[1] * h0[1]) + (h0[2] * h0[2] + h0[3] * h0[3]) + (h1[0] * h1[0] + h1[1] * h1[1]) + (h1[2] * h1[2] + h1[3] * h1[3]); }
                ss += shfl_xor_f(ss, 16, lane); ss += shfl_xor_f(ss, 32, lane);
                if (fq == 0) SSQ[(size_t)row * 64 + u.pn * 4 + wc] = ss; }
            return;
        }
        u32x4 rw[2][4][2];
#pragma unroll
        for (int ai = 0; ai < 2; ++ai)
#pragma unroll
            for (int m = 0; m < 4; ++m)
#pragma unroll
                for (int bj = 0; bj < 2; ++bj) rw[ai][m][bj] = *(const u32x4*)(HB + (size_t)(row0 + ai * HALF + m * 16) * ldc + col0 + bj * HALF);
        __builtin_amdgcn_sched_barrier(0);
#pragma unroll
        for (int ai = 0; ai < 2; ++ai)
#pragma unroll
            for (int m = 0; m < 4; ++m) { const int row = row0 + ai * HALF + m * 16; const size_t ro = (size_t)row * ldc + col0; float ss = 0.f;
#pragma unroll
                for (int bj = 0; bj < 2; ++bj) { const u32x4 w0 = rw[ai][m][bj];
                    const f32x4 r0 = (f32x4){__builtin_bit_cast(float, w0.x << 16), __builtin_bit_cast(float, w0.x & 0xffff0000u), __builtin_bit_cast(float, w0.y << 16), __builtin_bit_cast(float, w0.y & 0xffff0000u)};
                    const f32x4 r1 = (f32x4){__builtin_bit_cast(float, w0.z << 16), __builtin_bit_cast(float, w0.z & 0xffff0000u), __builtin_bit_cast(float, w0.w << 16), __builtin_bit_cast(float, w0.w & 0xffff0000u)};
                    const f32x4 h0 = r0 + acc[ai][bj][m][0], h1 = r1 + acc[ai][bj][m][1];
                    u32x4 w; w.x = cvt_pk_bf16(h0[0], h0[1]); w.y = cvt_pk_bf16(h0[2], h0[3]); w.z = cvt_pk_bf16(h1[0], h1[1]); w.w = cvt_pk_bf16(h1[2], h1[3]);
                    *(u32x4*)(HBout + ro + bj * HALF) = w;
                    ss += (h0[0] * h0[0] + h0[1] * h0[1]) + (h0[2] * h0[2] + h0[3] * h0[3]) + (h1[0] * h1[0] + h1[1] * h1[1]) + (h1[2] * h1[2] + h1[3] * h1[3]); }
                ss += shfl_xor_f(ss, 16, lane); ss += shfl_xor_f(ss, 32, lane);
                if (fq == 0) SSQ[(size_t)row * 64 + u.pn * 4 + wc] = ss; }
    }
};
struct EpiBf16S {
    static constexpr bool PERM = true, AFTER_DRAIN = false;
    bf16_t* O; int ldc; const PG8_LAS float* RSL; int row_base;
    __device__ __forceinline__ void operator()(const f32x4 (&acc)[2][2][4][2], const Unit& u, int wr, int wc, int fr, int fq) const {
        const int row0 = u.pm * BM + wr * 64 + fr, col0 = u.pn * BM + wc * 32 + 8 * fq;
#pragma unroll
        for (int ai = 0; ai < 2; ++ai)
#pragma unroll
            for (int m = 0; m < 4; ++m) { const int row = row0 + ai * HALF + m * 16; const float rs = RSL[row - row_base]; bf16_t* rowp = O + (size_t)row * ldc + col0;
#pragma unroll
                for (int bj = 0; bj < 2; ++bj) { const f32x4 v0 = acc[ai][bj][m][0] * rs, v1 = acc[ai][bj][m][1] * rs;
                    u32x4 w; w.x = cvt_pk_bf16(v0[0], v0[1]); w.y = cvt_pk_bf16(v0[2], v0[3]); w.z = cvt_pk_bf16(v1[0], v1[1]); w.w = cvt_pk_bf16(v1[2], v1[3]);
                    *(u32x4*)(rowp + bj * HALF) = w; } }
    }
};
struct EpiF32S {
    static constexpr bool PERM = false, AFTER_DRAIN = false;
    float* C; int ldc; const PG8_LAS float* RSL; int row_base;
    __device__ __forceinline__ void operator()(const f32x4 (&acc)[2][2][4][2], const Unit& u, int wr, int wc, int fr, int fq) const {
        const int row0 = u.pm * BM + wr * 64 + fr, col0 = u.pn * BM + wc * 32 + 4 * fq;
#pragma unroll
        for (int ai = 0; ai < 2; ++ai)
#pragma unroll
            for (int m = 0; m < 4; ++m) { const int row = row0 + ai * HALF + m * 16; const float rs = RSL[row - row_base]; float* rowp = C + (size_t)row * ldc + col0;
#pragma unroll
                for (int bj = 0; bj < 2; ++bj)
#pragma unroll
                    for (int n = 0; n < 2; ++n) *(f32x4*)(rowp + bj * HALF + n * 16) = acc[ai][bj][m][n] * rs; }
    }
};
template <int HM> struct EpiConvGateT {
    static constexpr bool PERM = true, AFTER_DRAIN = false;
    bf16_t* G; const PG8_LAS float* RSL; int row_base; const float* cw; const float* cb; bf16_t* UE;
    __device__ __forceinline__ void operator()(const f32x4 (&acc)[2][2][4][2], const Unit& u, int wr, int wc, int fr, int fq) const {
        constexpr int DFF_ = 11008, NFF_ = 22016;
        const int row0 = u.pm * BM + wr * 64 + fr, jg0 = u.pn * HALF + wc * 32 + 8 * fq;
        const bool f01 = (fr < 2), f0 = (fr < 1);
        f32x4 WG0[2], WG1[2], WG2[2], BG[2], WV0[2], WV1[2], WV2[2], BV[2];
#pragma unroll
        for (int n = 0; n < 2; ++n) { const int jg = jg0 + 4 * n;
            WG0[n] = *(const f32x4*)(cw + jg); WG1[n] = *(const f32x4*)(cw + NFF_ + jg); WG2[n] = *(const f32x4*)(cw + 2 * NFF_ + jg); BG[n] = *(const f32x4*)(cb + jg);
            WV0[n] = *(const f32x4*)(cw + DFF_ + jg); WV1[n] = *(const f32x4*)(cw + NFF_ + DFF_ + jg); WV2[n] = *(const f32x4*)(cw + 2 * NFF_ + DFF_ + jg); BV[n] = *(const f32x4*)(cb + DFF_ + jg); }
#pragma unroll
        for (int ai = 0; ai < 2; ++ai) {
            if (HM != 0 && HM == 2 - ai) continue;
            float rs[4];
#pragma unroll
            for (int m = 0; m < 4; ++m) rs[m] = RSL[row0 + ai * HALF + m * 16 - row_base];
            unsigned pk[4][4];
            const int run = (u.pm * BM + ai * HALF + wr * 64) >> 6;
#pragma unroll
            for (int n = 0; n < 2; ++n) { const int jg = jg0 + 4 * n;
                const f32x4 wg0 = WG0[n], wg1 = WG1[n], wg2 = WG2[n], bg = BG[n], wv0 = WV0[n], wv1 = WV1[n], wv2 = WV2[n], bv = BV[n];
                f32x4 ug[4], uv[4];
#pragma unroll
                for (int m = 0; m < 4; ++m) { ug[m] = acc[ai][0][m][n] * rs[m]; uv[m] = acc[ai][1][m][n] * rs[m]; }
                if (f01) { bf16_t* e = UE + ((size_t)run * 4 + fr) * NFF_ + jg; *(unsigned long long*)e = (unsigned long long)cvt_pk_bf16(ug[0][0], ug[0][1]) | ((unsigned long long)cvt_pk_bf16(ug[0][2], ug[0][3]) << 32);
                           *(unsigned long long*)(e + DFF_) = (unsigned long long)cvt_pk_bf16(uv[0][0], uv[0][1]) | ((unsigned long long)cvt_pk_bf16(uv[0][2], uv[0][3]) << 32); }
                if (fr >= 14) { bf16_t* e = UE + ((size_t)run * 4 + (fr - 12)) * NFF_ + jg; *(unsigned long long*)e = (unsigned long long)cvt_pk_bf16(ug[3][0], ug[3][1]) | ((unsigned long long)cvt_pk_bf16(ug[3][2], ug[3][3]) << 32);
                           *(unsigned long long*)(e + DFF_) = (unsigned long long)cvt_pk_bf16(uv[3][0], uv[3][1]) | ((unsigned long long)cvt_pk_bf16(uv[3][2], uv[3][3]) << 32); }
#pragma unroll
                for (int j = 0; j < 4; ++j) {
                    const float wg1z = f0 ? 0.f : wg1[j], wg1p = f0 ? wg1[j] : 0.f, wg0z = f01 ? 0.f : wg0[j], wg0p = f01 ? wg0[j] : 0.f;
                    const float wv1z = f0 ? 0.f : wv1[j], wv1p = f0 ? wv1[j] : 0.f, wv0z = f01 ? 0.f : wv0[j], wv0p = f01 ? wv0[j] : 0.f;
                    float g1p = 0.f, g2p = 0.f, v1p = 0.f, v2p = 0.f;
                    float gout[4];
#pragma unroll
                    for (int m = 0; m < 4; ++m) { const float xg = ug[m][j], xv = uv[m][j];
                        const float g1 = dpp_ror1(xg), g2 = dpp_ror2(xg), v1 = dpp_ror1(xv), v2 = dpp_ror2(xv);
                        float gate = bg[j] + wg2[j] * xg, val = bv[j] + wv2[j] * xv;
                        gate += wg1z * g1; val += wv1z * v1; gate += wg0z * g2; val += wv0z * v2;
                        if (m > 0) { gate += wg1p * g1p; val += wv1p * v1p; gate += wg0p * g2p; val += wv0p * v2p; }
                        g1p = g1; g2p = g2; v1p = v1; v2p = v2;
                        gout[m] = gate * __builtin_amdgcn_rcpf(1.0f + __builtin_amdgcn_exp2f(-1.4426950408889634f * gate)) * val;
                    }
                    if (j & 1) {
#pragma unroll
                        for (int m = 0; m < 4; ++m) pk[m][2 * n + (j >> 1)] = cvt_pk_bf16(__builtin_bit_cast(float, pk[m][2 * n + (j >> 1)]), gout[m]); }
                    else {
#pragma unroll
                        for (int m = 0; m < 4; ++m) pk[m][2 * n + (j >> 1)] = __builtin_bit_cast(unsigned, gout[m]); }
                }
            }
#pragma unroll
            for (int m = 0; m < 4; ++m) { u32x4 w; w.x = pk[m][0]; w.y = pk[m][1]; w.z = pk[m][2]; w.w = pk[m][3];
                *(u32x4*)(G + (size_t)(row0 + ai * HALF + m * 16) * DFF_ + jg0) = w; }
        }
    }
};
using EpiConvGate = EpiConvGateT<0>;
template <class Epi, class Sched, bool ALIGN_EPI = false, bool SP2 = false, int HM = 0  >
__device__ __forceinline__ void gemm_phase(PG8_LAS unsigned char* lds, const Gemm g, const Sched& S, const Epi& E, const int wid_in  ) {
    int lane_l = lane_id(); asm volatile("" : "+v"(lane_l));
    int wid_l = wid_in; asm volatile("" : "+s"(wid_l));
    const int wid = wid_l, lane = lane_l, tid = wid * 64 + lane, wr = wid >> 2, wc = wid & 3, fr = lane & 15, fq = lane >> 4;
    const int K = g.K, nt = K / BK, lda = g.lda;
    unsigned voffA[2], voffB[2];
#pragma unroll
    for (int i = 0; i < 2; ++i) { int R, C; stage_rc(tid * 16 + i * 8192, R, C); const int Rb = Epi::PERM ? ((R & ~31) + perm32(R & 31)) : R;
        voffA[i] = (unsigned)(R * lda + C) * 2u; voffB[i] = (unsigned)(Rb * K + C) * 2u; }
    const size_t kstep = (size_t)(BK * 2);
    const size_t hsA = (size_t)HALF * lda * 2, hsB = (size_t)HALF * K * 2;
    const size_t tsA = 2 * hsA, tsB = 2 * hsB;
    const unsigned ldsw = (unsigned)wid * 1024u;
    const int aoff = lds_byte(wr * 64 + fr, fq * 8), boff = lds_byte(wc * 32 + fr, fq * 8);
#define PG8_SA(b, h) (((b) * 2 + (h)) * HTB)
#define PG8_SB(b, h) ((4 + (b) * 2 + (h)) * HTB)
#define PG8_STAGE(bufoff, gbase, voff) do { _Pragma("unroll") for (int _i = 0; _i < 2; ++_i) \
        __builtin_amdgcn_global_load_lds((const unsigned*)((const char*)(gbase) + (voff)[_i]), (PG8_LAS unsigned*)(lds + (bufoff) + ldsw + _i * 8192), 16, 0, 0); } while (0)
#define PG8_LDA(dst, b, h) do { _Pragma("unroll") for (int m = 0; m < 4; ++m) _Pragma("unroll") for (int k = 0; k < 2; ++k) dst[m][k] = *(const PG8_LAS bf16x8*)(lds + PG8_SA(b, h) + aoff + m * 2048 + k * 1024); } while (0)
#define PG8_LDB(dst, b, h) do { _Pragma("unroll") for (int n = 0; n < 2; ++n) _Pragma("unroll") for (int k = 0; k < 2; ++k) dst[n][k] = *(const PG8_LAS bf16x8*)(lds + PG8_SB(b, h) + boff + n * 2048 + k * 1024); } while (0)
#define PG8_MMA(ai, bj, At, Bt) do { __builtin_amdgcn_s_setprio(1); _Pragma("unroll") for (int m = 0; m < 4; ++m) _Pragma("unroll") for (int n = 0; n < 2; ++n) _Pragma("unroll") for (int k = 0; k < 2; ++k) \
        acc[ai][bj][m][n] = __builtin_amdgcn_mfma_f32_16x16x32_bf16(Bt[n][k], At[m][k], acc[ai][bj][m][n], 0, 0, 0); __builtin_amdgcn_s_setprio(0); } while (0)
#define PG8_WAIT_V(n) asm volatile("s_waitcnt vmcnt(" #n ")" ::: "memory")
#define PG8_WAIT_L(n) asm volatile("s_waitcnt lgkmcnt(" #n ")" ::: "memory")
#define PG8_WAIT_VH() do { if constexpr (HM == 0) PG8_WAIT_V(8); else PG8_WAIT_V(6); } while (0)
#define PG8_BAR __builtin_amdgcn_s_barrier()
#define PG8_SCHED __builtin_amdgcn_sched_barrier(0)
    Unit cur, nxt; int ui = 0;
    if (!S.next(0, cur)) return;
    f32x4 acc[2][2][4][2];
#pragma unroll
    for (int a = 0; a < 2; ++a)
#pragma unroll
        for (int b = 0; b < 2; ++b)
#pragma unroll
            for (int m = 0; m < 4; ++m)
#pragma unroll
                for (int n = 0; n < 2; ++n) acc[a][b][m][n] = (f32x4){0.f, 0.f, 0.f, 0.f};
    bf16x8 At[4][2], B0[2][2], B1[2][2];
    const char* cA = (const char*)g.A + (size_t)cur.pm * tsA + (size_t)S.acol(cur) * 2; const char* cB = (const char*)g.Bt + (size_t)cur.pn * tsB;
    S.a_ready(cur);
    static_assert(SP2 || HM == 0, "half units: SP2 loop only");
    if constexpr (SP2) {
        PG8_STAGE(PG8_SB(0, 0), cB, voffB); PG8_STAGE(PG8_SB(0, 1), cB + hsB, voffB); PG8_STAGE(PG8_SA(0, 0), cA, voffA); PG8_STAGE(PG8_SA(0, 1), cA + hsA, voffA);
        if (wr == 1) PG8_BAR;
        PG8_WAIT_V(2); PG8_BAR;
        PG8_STAGE(PG8_SB(1, 0), cB + kstep, voffB); PG8_STAGE(PG8_SA(1, 0), cA + kstep, voffA); PG8_STAGE(PG8_SB(1, 1), cB + hsB + kstep, voffB);
        PG8_WAIT_V(6); PG8_BAR;
    } else {
        PG8_STAGE(PG8_SB(0, 0), cB, voffB); PG8_STAGE(PG8_SA(0, 0), cA, voffA); PG8_STAGE(PG8_SB(0, 1), cB + hsB, voffB); PG8_STAGE(PG8_SA(0, 1), cA + hsA, voffA);
        if (wr == 1) PG8_BAR;
        PG8_WAIT_V(4); PG8_BAR;
        PG8_STAGE(PG8_SB(1, 0), cB + kstep, voffB); PG8_STAGE(PG8_SA(1, 0), cA + kstep, voffA); PG8_STAGE(PG8_SB(1, 1), cB + hsB + kstep, voffB);
        PG8_WAIT_V(6); PG8_BAR;
    }
    for (;;) {
        const bool has_next = S.next(ui + 1, nxt);
        const char* nA = has_next ? (const char*)g.A + (size_t)nxt.pm * tsA + (size_t)S.acol(nxt) * 2 : cA; const char* nB = has_next ? (const char*)g.Bt + (size_t)nxt.pn * tsB : cB;
        for (int t = 0; t < nt; t += 2) {
            const bool last = (t == nt - 2);
            const char* a1 = cA + (size_t)(t + 1) * kstep;
            const char* a2 = last ? nA : cA + (size_t)(t + 2) * kstep; const char* b2 = last ? nB : cB + (size_t)(t + 2) * kstep;
            const char* a3 = a2 + kstep; const char* b3 = b2 + kstep;
            if (last && has_next) S.a_ready(nxt);
            if constexpr (SP2) {
            PG8_LDB(B0, 0, 0); PG8_LDB(B1, 0, 1); PG8_SCHED; if constexpr (HM != 2) PG8_LDA(At, 0, 0); if constexpr (HM != 1) PG8_STAGE(PG8_SA(1, 1), a1 + hsA, voffA);
            PG8_WAIT_VH(); PG8_WAIT_L(0); PG8_BAR; if constexpr (HM != 2) { PG8_MMA(0, 0, At, B0); PG8_MMA(0, 1, At, B1); } PG8_BAR; PG8_SCHED;
            if constexpr (HM != 1) PG8_LDA(At, 0, 1); PG8_STAGE(PG8_SB(0, 0), b2, voffB); PG8_STAGE(PG8_SB(0, 1), b2 + hsB, voffB); if constexpr (HM != 2) PG8_STAGE(PG8_SA(0, 0), a2, voffA);
            PG8_WAIT_VH(); PG8_WAIT_L(0); PG8_BAR; if constexpr (HM != 1) { PG8_MMA(1, 0, At, B0); PG8_MMA(1, 1, At, B1); } PG8_BAR; PG8_SCHED;
            PG8_LDB(B0, 1, 0); PG8_LDB(B1, 1, 1); PG8_SCHED; if constexpr (HM != 2) PG8_LDA(At, 1, 0); if constexpr (HM != 1) PG8_STAGE(PG8_SA(0, 1), a2 + hsA, voffA);
            PG8_WAIT_VH(); PG8_WAIT_L(0); PG8_BAR; if constexpr (HM != 2) { PG8_MMA(0, 0, At, B0); PG8_MMA(0, 1, At, B1); } PG8_BAR; PG8_SCHED;
            if constexpr (HM != 1) PG8_LDA(At, 1, 1); PG8_STAGE(PG8_SB(1, 0), b3, voffB); PG8_STAGE(PG8_SB(1, 1), b3 + hsB, voffB); if constexpr (HM != 2) PG8_STAGE(PG8_SA(1, 0), a3, voffA);
            PG8_WAIT_VH(); PG8_WAIT_L(0); PG8_BAR; if constexpr (HM != 1) { PG8_MMA(1, 0, At, B0); PG8_MMA(1, 1, At, B1); } PG8_BAR; PG8_SCHED;
            } else {
            PG8_LDB(B0, 0, 0); PG8_SCHED; PG8_LDA(At, 0, 0); PG8_STAGE(PG8_SA(1, 1), a1 + hsA, voffA);
            PG8_WAIT_L(8); PG8_BAR; PG8_WAIT_L(0); PG8_MMA(0, 0, At, B0); PG8_BAR; PG8_SCHED;
            PG8_LDB(B1, 0, 1); PG8_STAGE(PG8_SB(0, 0), b2, voffB);
            PG8_BAR; PG8_WAIT_L(0); PG8_MMA(0, 1, At, B1); PG8_BAR;
            PG8_LDA(At, 0, 1); PG8_STAGE(PG8_SA(0, 0), a2, voffA);
            PG8_BAR; PG8_WAIT_L(0); PG8_MMA(1, 0, At, B0); PG8_BAR; PG8_SCHED;
            PG8_STAGE(PG8_SB(0, 1), b2 + hsB, voffB);
            PG8_WAIT_V(6); PG8_BAR; PG8_MMA(1, 1, At, B1); PG8_BAR;
            PG8_LDB(B0, 1, 0); PG8_SCHED; PG8_LDA(At, 1, 0); PG8_STAGE(PG8_SA(0, 1), a2 + hsA, voffA);
            PG8_WAIT_L(8); PG8_BAR; PG8_WAIT_L(0); PG8_MMA(0, 0, At, B0); PG8_BAR; PG8_SCHED;
            PG8_LDB(B1, 1, 1); PG8_STAGE(PG8_SB(1, 0), b3, voffB);
            PG8_BAR; PG8_WAIT_L(0); PG8_MMA(0, 1, At, B1); PG8_BAR;
            PG8_LDA(At, 1, 1); PG8_STAGE(PG8_SA(1, 0), a3, voffA);
            PG8_BAR; PG8_WAIT_L(0); PG8_MMA(1, 0, At, B0); PG8_BAR; PG8_SCHED;
            PG8_STAGE(PG8_SB(1, 1), b3 + hsB, voffB);
            PG8_WAIT_V(6); PG8_BAR; PG8_MMA(1, 1, At, B1); PG8_BAR;
            }
        }
        if constexpr (ALIGN_EPI) { if (wr == 0) PG8_BAR; }
        if constexpr (!Epi::AFTER_DRAIN) { E(acc, cur, wr, wc, fr, fq); S.done(cur); }
        if (!has_next) break;
#pragma unroll
        for (int a = 0; a < 2; ++a)
#pragma unroll
            for (int b = 0; b < 2; ++b)
#pragma unroll
                for (int m = 0; m < 4; ++m)
#pragma unroll
                    for (int n = 0; n < 2; ++n) acc[a][b][m][n] = (f32x4){0.f, 0.f, 0.f, 0.f};
        cur = nxt; cA = nA; cB = nB; ++ui;
        if constexpr (ALIGN_EPI) { if (wr == 1) PG8_BAR; }
    }
    PG8_WAIT_V(0);
    if constexpr (!ALIGN_EPI) { if (wr == 0) PG8_BAR; }
    PG8_BAR;
    if constexpr (Epi::AFTER_DRAIN) { E.fused(acc, cur, wr, wc, fr, fq, lds, wid, lane); S.done(cur); }
#undef PG8_SA
#undef PG8_SB
#undef PG8_STAGE
#undef PG8_LDA
#undef PG8_LDB
#undef PG8_MMA
#undef PG8_WAIT_V
#undef PG8_WAIT_VH
#undef PG8_WAIT_L
#undef PG8_BAR
#undef PG8_SCHED
}
}
namespace mla {
typedef unsigned short bf16;
typedef short bf16x8 __attribute__((ext_vector_type(8)));
typedef short s16x4 __attribute__((ext_vector_type(4)));
typedef float f32x4 __attribute__((ext_vector_type(4)));
typedef unsigned u32x4 __attribute__((ext_vector_type(4)));
typedef unsigned u32x2 __attribute__((ext_vector_type(2)));
typedef __attribute__((address_space(3))) unsigned char lds_uc;
constexpr int DQK = 192, DV = 128, NW = 8, QBLK = 32, KVBLK = 64, QB = NW * QBLK;
constexpr int PQ = 6144, PKV = 8192, PKR = 64, PO = 4096;
constexpr int KROW = 416, VROW = 288;
constexpr int KGR = KROW / 16, VGR = VROW / 16;
constexpr int SHM_K = KVBLK * KROW, SHM_V = KVBLK * VROW;
constexpr int NVB = 3, NKB = 2;
constexpr int OFF_V = 0, OFF_K = NVB * SHM_V, QX_OFF = OFF_K + NKB * SHM_K;
constexpr int LDS_BYTES = QX_OFF + NW * 4096;
constexpr float SCALE = 0.07216878364870322f, THR = 8.f;
constexpr float C2 = 1.4426950408889634f * SCALE;
#define SBAR() __builtin_amdgcn_sched_barrier(0)
#define VMW() asm volatile("s_waitcnt vmcnt(0)" ::: "memory")
#define GCH const __attribute__((address_space(1))) char
__device__ __forceinline__ unsigned cvtpk(float lo, float hi) { unsigned r; asm volatile("v_cvt_pk_bf16_f32 %0, %1, %2" : "=v"(r) : "v"(lo), "v"(hi)); return r; }
__device__ __forceinline__ float max3f(float a, float b, float c) { float r; asm("v_max3_f32 %0, %1, %2, %3" : "=v"(r) : "v"(a), "v"(b), "v"(c)); return r; }
__device__ __forceinline__ float max2f(float a, float b) { float r; asm("v_max_f32_e32 %0, %1, %2" : "=v"(r) : "v"(a), "v"(b)); return r; }
__device__ __forceinline__ float red16_max(float v) { auto r = __builtin_amdgcn_permlane16_swap(__float_as_uint(v), __float_as_uint(v), false, false); v = max2f(__uint_as_float(r[0]), __uint_as_float(r[1]));
    auto q = __builtin_amdgcn_permlane32_swap(__float_as_uint(v), __float_as_uint(v), false, false); return max2f(__uint_as_float(q[0]), __uint_as_float(q[1])); }
__device__ __forceinline__ float red16_sum(float v) { auto r = __builtin_amdgcn_permlane16_swap(__float_as_uint(v), __float_as_uint(v), false, false); v = __uint_as_float(r[0]) + __uint_as_float(r[1]);
    auto q = __builtin_amdgcn_permlane32_swap(__float_as_uint(v), __float_as_uint(v), false, false); return __uint_as_float(q[0]) + __uint_as_float(q[1]); }
struct Tensors { const bf16* Q; const bf16* KV; const bf16* KR; bf16* O; const float* T; };
struct BlockRef { const bf16* Q; const bf16* Kn; bf16* O; int P0; int desc; };
struct Seam { bf16x8 qf[2][4]; int g, vs; };
struct DmaOff { unsigned k[4], v[3]; };
__device__ __forceinline__ DmaOff dma_offsets(int wid, int lane) {
    DmaOff d;
#pragma unroll
    for (int i = 0; i < 4; ++i) { const int L = (i * 8 + wid) * 64 + lane, row = L / KGR, pc = L - row * KGR, c = pc < 24 ? pc : 0;
        d.k[i] = c < 16 ? (unsigned)(row * (PKV * 2) + c * 16) : (0x80000000u | (unsigned)(row * (PKR * 2) + (c - 16) * 16)); }
#pragma unroll
    for (int i = 0; i < 3; ++i) { const int L = (i * 8 + wid) * 64 + lane, row = L / VGR, pc = L - row * VGR, c = pc < 16 ? pc : 0;
        d.v[i] = (unsigned)(row * (PKV * 2) + c * 16) + 256u; }
    return d;
}
__device__ __forceinline__ void dma_tile(const bf16* Kn, const bf16* Kr, int k0, int ks, int vs, lds_uc* ldsl, int wid, const DmaOff& d) {
    typedef __attribute__((address_space(3))) unsigned LU;
    const char* kvb = (const char*)Kn + (size_t)k0 * (PKV * 2); const char* krb = (const char*)Kr + (size_t)k0 * (PKR * 2);
#pragma unroll
    for (int i = 0; i < 4; ++i) { if (i == 3 && wid >= 2) break;
        const char* src = ((int)d.k[i] < 0 ? krb : kvb) + (d.k[i] & 0x7fffffffu);
        __builtin_amdgcn_global_load_lds((const unsigned*)src, (LU*)(ldsl + OFF_K + ks * SHM_K + (i * 8 + wid) * 1024), 16, 0, 0); }
#pragma unroll
    for (int i = 0; i < 3; ++i) { if (i == 2 && wid >= 2) break;
        __builtin_amdgcn_global_load_lds((const unsigned*)(kvb + d.v[i]), (LU*)(ldsl + OFF_V + vs * SHM_V + (i * 8 + wid) * 1024), 16, 0, 0); }
}
struct DmaReq { const bf16* Kn; const bf16* Kr; int k0, ks, vs; lds_uc* ldsl; int wid; bool on; };
__device__ __forceinline__ void qkt(f32x4 (&st)[4][2], const char* klb, const bf16x8 (&qf)[2][4], const char* qx, const DmaReq& rq_, const DmaOff& doff_) {
#pragma unroll
    for (int i = 0; i < 4; ++i) { st[i][0] = (f32x4){0.f, 0.f, 0.f, 0.f}; st[i][1] = (f32x4){0.f, 0.f, 0.f, 0.f}; }
#define KLD(n, dst) do { dst = *reinterpret_cast<const bf16x8*>(klb + ((n) & 3) * 16 * KROW + ((n) >> 2) * 64); } while (0)
    bf16x8 k0, k1, k2, k3, q4a, q4b, q5a, q5b;
    KLD(0, k0); KLD(1, k1); KLD(2, k2); KLD(3, k3); SBAR();
#pragma unroll
    for (int s = 0; s < 6; ++s) {
        if (s == 3) { q4a = *reinterpret_cast<const bf16x8*>(qx); q4b = *reinterpret_cast<const bf16x8*>(qx + 1024); }
        if (s == 4) { q5a = *reinterpret_cast<const bf16x8*>(qx + 2048); q5b = *reinterpret_cast<const bf16x8*>(qx + 3072); }
        SBAR();
        const bf16x8 qa = s < 4 ? qf[0][s < 4 ? s : 0] : (s == 4 ? q4a : q5a), qb = s < 4 ? qf[1][s < 4 ? s : 0] : (s == 4 ? q4b : q5b);
#define SLOT(i, kk) do { st[i][0] = __builtin_amdgcn_mfma_f32_16x16x32_bf16(kk, qa, st[i][0], 0, 0, 0); st[i][1] = __builtin_amdgcn_mfma_f32_16x16x32_bf16(kk, qb, st[i][1], 0, 0, 0); \
            SBAR(); if (s < 5) KLD(4 * (s + 1) + (i), kk); SBAR(); } while (0)
        SLOT(0, k0); SLOT(1, k1); SLOT(2, k2); SLOT(3, k3);
#undef SLOT
        if (s == 0) { if (rq_.on) dma_tile(rq_.Kn, rq_.Kr, rq_.k0, rq_.ks, rq_.vs, rq_.ldsl, rq_.wid, doff_); SBAR(); }
    }
#undef KLD
}
__device__ __forceinline__ void mask_tile(f32x4 (&st)[4][2], int dq0, int dq1) {
    const float NEG = -__builtin_inff();
#pragma unroll
    for (int i = 0; i < 4; ++i)
#pragma unroll
        for (int r = 0; r < 4; ++r) { if (16 * i + r > dq0) st[i][0][r] = NEG; if (16 * i + r > dq1) st[i][1][r] = NEG; }
}
__device__ __forceinline__ bool partialSM(f32x4 (&st)[4][2], float (&m)[2], float (&al)[2]) {
    float pm[2];
#pragma unroll
    for (int j = 0; j < 2; ++j) { float a = max3f(st[0][j][0], st[0][j][1], st[0][j][2]), b = max3f(st[0][j][3], st[1][j][0], st[1][j][1]);
        a = max3f(a, st[1][j][2], st[1][j][3]); b = max3f(b, st[2][j][0], st[2][j][1]); a = max3f(a, st[2][j][2], st[2][j][3]); b = max3f(b, st[3][j][0], st[3][j][1]); a = max3f(a, st[3][j][2], st[3][j][3]);
        pm[j] = max2f(a, b); }
    float mn[2];
    const bool keep = __all((pm[0] - m[0]) * SCALE <= THR && (pm[1] - m[1]) * SCALE <= THR);
    if (__builtin_expect(keep, 1)) { mn[0] = m[0]; mn[1] = m[1]; al[0] = 1.f; al[1] = 1.f; }
    else {
#pragma unroll
        for (int j = 0; j < 2; ++j) { mn[j] = max2f(m[j], red16_max(pm[j])); al[j] = __builtin_amdgcn_exp2f((m[j] - mn[j]) * C2); m[j] = mn[j]; } }
#pragma unroll
    for (int j = 0; j < 2; ++j) { const float mnL = -mn[j] * C2;
#pragma unroll
        for (int i = 0; i < 4; ++i)
#pragma unroll
            for (int r = 0; r < 4; ++r) st[i][j][r] = fmaf(st[i][j][r], C2, mnL); }
#pragma unroll
    for (int i = 0; i < 4; ++i)
#pragma unroll
        for (int r = 0; r < 4; ++r) st[i][0][r] = __builtin_amdgcn_exp2f(st[i][0][r]);
    return keep;
}
__device__ __forceinline__ void finishSM(f32x4 (&st)[4][2], bf16x8 (&pb)[2][2]) {
#pragma unroll
    for (int i = 0; i < 4; ++i)
#pragma unroll
        for (int r = 0; r < 4; ++r) st[i][1][r] = __builtin_amdgcn_exp2f(st[i][1][r]);
#pragma unroll
    for (int j = 0; j < 2; ++j)
#pragma unroll
        for (int b = 0; b < 2; ++b) { u32x4 w = {cvtpk(st[2 * b][j][0], st[2 * b][j][1]), cvtpk(st[2 * b][j][2], st[2 * b][j][3]), cvtpk(st[2 * b + 1][j][0], st[2 * b + 1][j][1]), cvtpk(st[2 * b + 1][j][2], st[2 * b + 1][j][3])};
            pb[j][b] = *reinterpret_cast<bf16x8*>(&w); }
}
__device__ __forceinline__ void pv_tile(f32x4 (&ot)[8][2], f32x4 (&lt)[2], int vb0, const bf16x8 (&pb)[2][2]) {
#define TRRD(dst, off) asm volatile("ds_read_b64_tr_b16 %0, %1 offset:%2" : "=&v"(dst) : "v"(vb0), "i"(off) : "memory")
#define PV_RD(n, lo, hi) do { SBAR(); TRRD(lo, ((n) >> 3) * 32 * VROW + ((n) & 7) * 32); TRRD(hi, ((n) >> 3) * 32 * VROW + 16 * VROW + ((n) & 7) * 32); SBAR(); } while (0)
#define PV_W(k) do { asm volatile("s_waitcnt lgkmcnt(" #k ")" ::: "memory"); SBAR(); } while (0)
#define PV_MM(n, lo, hi) do { const bf16x8 vf_ = {lo[0], lo[1], lo[2], lo[3], hi[0], hi[1], hi[2], hi[3]};                                  \
        ot[(n) & 7][0] = __builtin_amdgcn_mfma_f32_16x16x32_bf16(vf_, pb[0][(n) >> 3], ot[(n) & 7][0], 0, 0, 0);                           \
        ot[(n) & 7][1] = __builtin_amdgcn_mfma_f32_16x16x32_bf16(vf_, pb[1][(n) >> 3], ot[(n) & 7][1], 0, 0, 0); SBAR(); } while (0)
    s16x4 al_, ah_, bl_, bh_, cl_, ch_, dl_, dh_;
    PV_RD(0, al_, ah_); PV_RD(1, bl_, bh_); PV_RD(2, cl_, ch_);
    { const bf16x8 ones_ = {0x3F80, 0x3F80, 0x3F80, 0x3F80, 0x3F80, 0x3F80, 0x3F80, 0x3F80};
      lt[0] = __builtin_amdgcn_mfma_f32_16x16x32_bf16(ones_, pb[0][0], lt[0], 0, 0, 0); lt[1] = __builtin_amdgcn_mfma_f32_16x16x32_bf16(ones_, pb[1][0], lt[1], 0, 0, 0);
      lt[0] = __builtin_amdgcn_mfma_f32_16x16x32_bf16(ones_, pb[0][1], lt[0], 0, 0, 0); lt[1] = __builtin_amdgcn_mfma_f32_16x16x32_bf16(ones_, pb[1][1], lt[1], 0, 0, 0); SBAR(); }
#pragma unroll
    for (int n = 0; n < 16; n += 4) {
        PV_RD(n + 3, dl_, dh_); PV_W(6); PV_MM(n, al_, ah_);
        if (n + 4 < 16) { PV_RD(n + 4, al_, ah_); PV_W(6); } else PV_W(4);
        PV_MM(n + 1, bl_, bh_);
        if (n + 5 < 16) { PV_RD(n + 5, bl_, bh_); PV_W(6); } else PV_W(2);
        PV_MM(n + 2, cl_, ch_);
        if (n + 6 < 16) { PV_RD(n + 6, cl_, ch_); PV_W(6); } else PV_W(0);
        PV_MM(n + 3, dl_, dh_);
    }
#undef TRRD
#undef PV_RD
#undef PV_W
#undef PV_MM
}
__device__ __forceinline__ bool pv_ps(f32x4 (&ot)[8][2], f32x4 (&lt)[2], int vb0, const bf16x8 (&pb)[2][2], f32x4 (&x)[4][2], float (&m)[2], float (&al)[2]) {
#define TRRD(dst, off) asm volatile("ds_read_b64_tr_b16 %0, %1 offset:%2" : "=&v"(dst) : "v"(vb0), "i"(off) : "memory")
#define PV_RD(n, lo, hi) do { SBAR(); TRRD(lo, ((n) >> 3) * 32 * VROW + ((n) & 7) * 32); TRRD(hi, ((n) >> 3) * 32 * VROW + 16 * VROW + ((n) & 7) * 32); SBAR(); } while (0)
#define PV_W(k) do { asm volatile("s_waitcnt lgkmcnt(" #k ")" ::: "memory"); SBAR(); } while (0)
#define PV_MM(n, lo, hi) do { const bf16x8 vf_ = {lo[0], lo[1], lo[2], lo[3], hi[0], hi[1], hi[2], hi[3]};                                  \
        ot[(n) & 7][0] = __builtin_amdgcn_mfma_f32_16x16x32_bf16(vf_, pb[0][(n) >> 3], ot[(n) & 7][0], 0, 0, 0);                           \
        ot[(n) & 7][1] = __builtin_amdgcn_mfma_f32_16x16x32_bf16(vf_, pb[1][(n) >> 3], ot[(n) & 7][1], 0, 0, 0); } while (0)
    s16x4 al_, ah_, bl_, bh_, cl_, ch_, dl_, dh_;
    float pa0, pb0, pa1, pb1, mn[2] = {0.f, 0.f}, mnL0 = 0.f, mnL1 = 0.f; bool keep = true;
    PV_RD(0, al_, ah_); PV_RD(1, bl_, bh_); PV_RD(2, cl_, ch_);
    { const bf16x8 ones_ = {0x3F80, 0x3F80, 0x3F80, 0x3F80, 0x3F80, 0x3F80, 0x3F80, 0x3F80};
      lt[0] = __builtin_amdgcn_mfma_f32_16x16x32_bf16(ones_, pb[0][0], lt[0], 0, 0, 0); lt[1] = __builtin_amdgcn_mfma_f32_16x16x32_bf16(ones_, pb[1][0], lt[1], 0, 0, 0);
      lt[0] = __builtin_amdgcn_mfma_f32_16x16x32_bf16(ones_, pb[0][1], lt[0], 0, 0, 0); lt[1] = __builtin_amdgcn_mfma_f32_16x16x32_bf16(ones_, pb[1][1], lt[1], 0, 0, 0); SBAR(); }
#define FILL(n) do { \
        if ((n) == 0) { pa0 = max3f(x[0][0][0], x[0][0][1], x[0][0][2]); pb0 = max3f(x[0][0][3], x[1][0][0], x[1][0][1]); pa0 = max3f(pa0, x[1][0][2], x[1][0][3]); pb0 = max3f(pb0, x[2][0][0], x[2][0][1]); } \
        if ((n) == 1) { pa0 = max3f(pa0, x[2][0][2], x[2][0][3]); pb0 = max3f(pb0, x[3][0][0], x[3][0][1]); pa0 = max3f(pa0, x[3][0][2], x[3][0][3]); pa0 = max2f(pa0, pb0); } \
        if ((n) == 2) { pa1 = max3f(x[0][1][0], x[0][1][1], x[0][1][2]); pb1 = max3f(x[0][1][3], x[1][1][0], x[1][1][1]); pa1 = max3f(pa1, x[1][1][2], x[1][1][3]); pb1 = max3f(pb1, x[2][1][0], x[2][1][1]); } \
        if ((n) == 3) { pa1 = max3f(pa1, x[2][1][2], x[2][1][3]); pb1 = max3f(pb1, x[3][1][0], x[3][1][1]); pa1 = max3f(pa1, x[3][1][2], x[3][1][3]); pa1 = max2f(pa1, pb1); \
            keep = __all((pa0 - m[0]) * SCALE <= THR && (pa1 - m[1]) * SCALE <= THR); \
            if (__builtin_expect(keep, 1)) { mn[0] = m[0]; mn[1] = m[1]; al[0] = 1.f; al[1] = 1.f; } \
            else { mn[0] = max2f(m[0], red16_max(pa0)); al[0] = __builtin_amdgcn_exp2f((m[0] - mn[0]) * C2); m[0] = mn[0]; mn[1] = max2f(m[1], red16_max(pa1)); al[1] = __builtin_amdgcn_exp2f((m[1] - mn[1]) * C2); m[1] = mn[1]; } \
            mnL0 = -mn[0] * C2; mnL1 = -mn[1] * C2; } \
        if ((n) >= 4 && (n) < 8) { const int i_ = (n) - 4; x[i_][0][0] = fmaf(x[i_][0][0], C2, mnL0); x[i_][0][1] = fmaf(x[i_][0][1], C2, mnL0); x[i_][0][2] = fmaf(x[i_][0][2], C2, mnL0); x[i_][0][3] = fmaf(x[i_][0][3], C2, mnL0); } \
        if ((n) >= 8 && (n) < 12) { const int i_ = (n) - 8; x[i_][1][0] = fmaf(x[i_][1][0], C2, mnL1); x[i_][1][1] = fmaf(x[i_][1][1], C2, mnL1); x[i_][1][2] = fmaf(x[i_][1][2], C2, mnL1); x[i_][1][3] = fmaf(x[i_][1][3], C2, mnL1); } \
        if ((n) >= 12) { const int i_ = (n) - 12; x[i_][0][0] = __builtin_amdgcn_exp2f(x[i_][0][0]); x[i_][0][1] = __builtin_amdgcn_exp2f(x[i_][0][1]); x[i_][0][2] = __builtin_amdgcn_exp2f(x[i_][0][2]); x[i_][0][3] = __builtin_amdgcn_exp2f(x[i_][0][3]); } \
        SBAR(); } while (0)
#pragma unroll
    for (int n = 0; n < 16; n += 4) {
        PV_RD(n + 3, dl_, dh_); PV_W(6); PV_MM(n, al_, ah_); FILL(n);
        if (n + 4 < 16) { PV_RD(n + 4, al_, ah_); PV_W(6); } else PV_W(4);
        PV_MM(n + 1, bl_, bh_); FILL(n + 1);
        if (n + 5 < 16) { PV_RD(n + 5, bl_, bh_); PV_W(6); } else PV_W(2);
        PV_MM(n + 2, cl_, ch_); FILL(n + 2);
        if (n + 6 < 16) { PV_RD(n + 6, cl_, ch_); PV_W(6); } else PV_W(0);
        PV_MM(n + 3, dl_, dh_); FILL(n + 3);
    }
#undef TRRD
#undef PV_RD
#undef PV_W
#undef PV_MM
#undef FILL
    return keep;
}
__device__ __forceinline__ void rope2(bf16x8& x1f, bf16x8& x2f, const f32x4 (&cs)[4]) {
    u32x4 x1 = *reinterpret_cast<u32x4*>(&x1f), x2 = *reinterpret_cast<u32x4*>(&x2f), o1, o2;
#pragma unroll
    for (int p = 0; p < 4; ++p) { const f32x4 t = cs[p];
        const float a0 = __builtin_bit_cast(float, x1[p] << 16), a1 = __builtin_bit_cast(float, x1[p] & 0xffff0000u), b0 = __builtin_bit_cast(float, x2[p] << 16), b1 = __builtin_bit_cast(float, x2[p] & 0xffff0000u);
        o1[p] = cvtpk(a0 * t[0] - b0 * t[1], a1 * t[2] - b1 * t[3]); o2[p] = cvtpk(b0 * t[0] + a0 * t[1], b1 * t[2] + a1 * t[3]); }
    x1f = *reinterpret_cast<bf16x8*>(&o1); x2f = *reinterpret_cast<bf16x8*>(&o2);
}
#define LD8G(base, voff) (*(const __attribute__((address_space(1))) bf16x8*)((GCH*)(base) + (voff)))
#define LDT(base, voff) (*(const __attribute__((address_space(1))) f32x4*)((GCH*)(base) + (voff)))
#define QLOADS(R_) do { const int ln_ = lane_id(), c_ = ln_ & 15, g_ = ln_ >> 4;                                                                                     \
        _Pragma("unroll") for (int j_ = 0; j_ < 2; ++j_) { const unsigned voq_ = (unsigned)((wid * QBLK + 16 * j_ + c_) * PQ + 8 * g_) * 2u;                       \
            const unsigned vt_ = (unsigned)(((R_).P0 + wid * QBLK + 16 * j_ + c_) * 256 + g_ * 64);                                                                 \
            rq[j_][0] = LD8G((R_).Q, voq_ + 256); rq[j_][1] = LD8G((R_).Q, voq_ + 320);                                                                            \
            _Pragma("unroll") for (int p_ = 0; p_ < 4; ++p_) cs[j_][p_] = LDT(Tn.T, vt_ + 16 * p_);                                                                \
            _Pragma("unroll") for (int s_ = 0; s_ < 4; ++s_) S.qf[j_][s_] = LD8G((R_).Q, voq_ + 64 * s_); } } while (0)
#define QFIN() do { _Pragma("unroll") for (int j_ = 0; j_ < 2; ++j_) { rope2(rq[j_][0], rq[j_][1], cs[j_]);                                                      \
            *(bf16x8*)(qx + j_ * 1024) = rq[j_][0]; *(bf16x8*)(qx + 2048 + j_ * 1024) = rq[j_][1]; } } while (0)
#define VNEXT(v) ((v) == 2 ? 0 : (v) + 1)
#define FIRST_K0(R_) ((R_).desc ? (((R_).P0 + QB - 1) / KVBLK) * KVBLK : 0)
__device__ __forceinline__ void prime(const Tensors& Tn, const BlockRef& cur, char* lds, lds_uc* ldsl, Seam& S, const int wid_in) {
    int lane_l = lane_id(); asm volatile("" : "+v"(lane_l));
    int wid_l = wid_in; asm volatile("" : "+s"(wid_l));
    const int wid = wid_l, lane = lane_l;
    char* qx = lds + QX_OFF + wid * 4096 + lane * 16; bf16x8 rq[2][2]; f32x4 cs[2][4];
    S.g = 0; S.vs = 0;
    { const DmaOff d0_ = dma_offsets(wid, lane); dma_tile(cur.Kn, Tn.KR, FIRST_K0(cur), 0, 0, ldsl, wid, d0_); }
    QLOADS(cur);
    VMW();
    QFIN();
    __syncthreads();
}
__device__ __forceinline__ void block(const Tensors& Tn, const BlockRef& cur, const BlockRef& nxt, const bool has_nxt, char* lds, lds_uc* ldsl, Seam& S, const int wid_in) {
    int lane_l = lane_id(); asm volatile("" : "+v"(lane_l));
    int wid_l = wid_in; asm volatile("" : "+s"(wid_l));
    const int wid = wid_l, lane = lane_l, c = lane & 15, g = lane >> 4;
    const int NT = (cur.P0 + QB - 1) / KVBLK + 1;
    const int qlo = cur.P0 + wid * QBLK, dqb = qlo + c - 4 * g;
    const char* klb0 = lds + OFF_K + c * KROW + 16 * g;
    const int vbb = (int)(uintptr_t)(lds + OFF_V) + (4 * g + (c >> 2)) * VROW + 8 * (lane & 3);
    char* qx = lds + QX_OFF + wid * 4096 + lane * 16;
    float m[2] = {-1e30f, -1e30f}; f32x4 ot[8][2], lt[2] = {(f32x4){0.f, 0.f, 0.f, 0.f}, (f32x4){0.f, 0.f, 0.f, 0.f}};
#pragma unroll
    for (int t = 0; t < 8; ++t) { ot[t][0] = (f32x4){0.f, 0.f, 0.f, 0.f}; ot[t][1] = (f32x4){0.f, 0.f, 0.f, 0.f}; }
    const DmaOff doff = dma_offsets(wid, lane);
    const int gt0 = S.g; int vp = S.vs;
#define KBASE(t) ((cur.desc ? NT - 1 - (t) : (t)) * KVBLK)
#define KSLOT(t) (klb0 + ((gt0 + (t)) & 1) * SHM_K)
#define MASKT(X, t) do { const int kb_ = KBASE(t); if (kb_ + KVBLK - 1 > qlo) mask_tile(X, dqb - kb_, dqb + 16 - kb_); } while (0)
#define RESC(keep_, a) do { if (!(keep_)) { _Pragma("unroll") for (int t_ = 0; t_ < 8; ++t_) { ot[t_][0] *= (a)[0]; ot[t_][1] *= (a)[1]; } lt[0] *= (a)[0]; lt[1] *= (a)[1]; } } while (0)
    f32x4 pA[4][2], pB[4][2]; float alA[2], alB[2]; bf16x8 pb[2][2];
    { const DmaReq rq0_{cur.Kn, Tn.KR, KBASE(1), (gt0 + 1) & 1, VNEXT(vp), ldsl, wid, true}; qkt(pA, KSLOT(0), S.qf, qx, rq0_, doff); }
    MASKT(pA, 0); { const bool kp_ = partialSM(pA, m, alA); RESC(kp_, alA); }
    VMW(); __syncthreads();
#define STEP(PX, alX, PY, alY, t) do { (void)alY;                                                                              \
        { const int vd_ = vp == 0 ? 2 : vp - 1; const bool in_ = (t) + 1 < NT;     \
          const DmaReq rq_{in_ ? cur.Kn : nxt.Kn, Tn.KR, in_ ? KBASE((t) + 1) : FIRST_K0(nxt), (gt0 + (t) + 1) & 1, vd_, ldsl, wid, in_ || has_nxt}; \
          SBAR(); qkt(PX, KSLOT(t), S.qf, qx, rq_, doff); }                                                                     \
        finishSM(PY, pb); SBAR();                                                                                              \
        MASKT(PX, (t));                                                            \
        { const bool kp_ = pv_ps(ot, lt, vbb + vp * SHM_V, pb, PX, m, alX); vp = VNEXT(vp); RESC(kp_, alX); }                  \
        VMW(); __syncthreads(); } while (0)
    for (int t = 1; t + 1 < NT; t += 2) {
        STEP(pB, alB, pA, alA, t);
        STEP(pA, alA, pB, alB, t + 1);
    }
    STEP(pB, alB, pA, alA, NT - 1);
    bf16x8 rq[2][2]; f32x4 cs[2][4];
    if (has_nxt) QLOADS(nxt);
    SBAR();
    finishSM(pB, pb); SBAR();
    pv_tile(ot, lt, vbb + vp * SHM_V, pb); vp = VNEXT(vp);
    SBAR();
    if (has_nxt) { VMW(); QFIN(); }
    S.g = gt0 + NT; S.vs = vp;
    { const float rl0 = __builtin_amdgcn_rcpf(lt[0][0]), rl1 = __builtin_amdgcn_rcpf(lt[1][0]);
      __attribute__((address_space(1))) char* Ob = (__attribute__((address_space(1))) char*)cur.O; const unsigned voo = (unsigned)((wid * QBLK + c) * PO + 4 * g) * 2u;
#pragma unroll
      for (int t = 0; t < 8; ++t) { const f32x4 a = ot[t][0] * rl0, b = ot[t][1] * rl1;
          *(__attribute__((address_space(1))) u32x2*)(Ob + (voo + (unsigned)(16 * t) * 2u)) = (u32x2){cvtpk(a[0], a[1]), cvtpk(a[2], a[3])};
          *(__attribute__((address_space(1))) u32x2*)(Ob + (voo + (unsigned)(16 * PO + 16 * t) * 2u)) = (u32x2){cvtpk(b[0], b[1]), cvtpk(b[2], b[3])}; } }
#undef KBASE
#undef KSLOT
#undef MASKT
#undef RESC
#undef STEP
}
#undef QLOADS
#undef QFIN
#undef VNEXT
#undef FIRST_K0
#undef LD8G
#undef LDT
#undef GCH
#undef VMW
__device__ __forceinline__ BlockRef mkref(const Tensors& T, int L, int pass) {
    const int xcd = L & 7, k = L >> 3, h = (k >> 5) * 8 + xcd, x = k & 31, qb = pass ? x : 63 - x;
    BlockRef r; r.Q = T.Q + (size_t)qb * QB * PQ + h * DQK; r.Kn = T.KV + h * 256; r.O = T.O + (size_t)qb * QB * PO + h * DV; r.P0 = qb * QB; r.desc = pass; return r;
}
__device__ __forceinline__ void attn_phase(char* lds, lds_uc* ldsl, const Tensors& T, int G, int c, const int wid_in) {
    constexpr int total = 1024;
    int L = c; if (L >= total) return;
    int pass = 0; BlockRef cur = mkref(T, L, 0);
    if (wid_in >= 4) __builtin_amdgcn_s_setprio(1);
    Seam S; prime(T, cur, lds, ldsl, S, wid_in);
    for (;;) {
        const bool more_pass = pass == 0, more_item = L + G < total, last = !more_pass && !more_item;
        int passn = pass + 1, Ln = L; if (!more_pass) { passn = 0; Ln = more_item ? L + G : L; }
        const BlockRef nxt = last ? cur : mkref(T, Ln, passn);
        block(T, cur, nxt, !last, lds, ldsl, S, wid_in);
        if (last) break;
        cur = nxt; pass = passn; L = Ln;
    }
    __builtin_amdgcn_s_setprio(0);
}
}
constexpr int NWAVES = 8;
constexpr int S_ = 16384, DM = 4096, DFF = 11008, NFF = 22016, NH = 32;
constexpr int NDKVQ = 1792;
constexpr float EPS = 1e-6f;
constexpr int NPH = 14;
#ifndef MK_N_LAUNCHES
#define MK_N_LAUNCHES 1
#endif
constexpr int N_LAUNCHES = MK_N_LAUNCHES;
constexpr size_t MiB = 1u << 20;
constexpr size_t WS_CTL = 0, CTL_ZERO_BYTES = 64 * 1024;
constexpr size_t WS_ROPE = 2 * MiB;
constexpr size_t WS_WPOOL = 8 * MiB, WS_WDKVQ = 16 * MiB, WS_WUKV = 30 * MiB, WS_WUQ = 38 * MiB, WS_WO = 50 * MiB, WS_WIN = 82 * MiB, WS_WOUT = 426 * MiB;
constexpr size_t WIN_L = 172 * MiB, WOUT_L = 86 * MiB;
constexpr size_t WS_H = 598 * MiB;
constexpr size_t WS_XN = 854 * MiB;
constexpr size_t WS_XPB = 982 * MiB;
constexpr size_t WS_UE = 1600 * MiB;
constexpr size_t WS_SSQ = 1644 * MiB;
constexpr size_t WS_DUMMY2 = 598 * MiB;
constexpr size_t WS_DUMMY = 1144 * MiB;
constexpr size_t WS_G = 1670 * MiB;
constexpr size_t WS_CR = 982 * MiB, WS_CKVN = 1094 * MiB, WS_KR = 1110 * MiB, WS_CQN = 1112 * MiB, WS_KV = 1144 * MiB, WS_Q = 1400 * MiB;
constexpr size_t WS_O = 1670 * MiB;
constexpr size_t WS_END = 2014 * MiB;
constexpr int CW_TMO = 0, CW_CODE = 1, CW_BAR = 4096;
constexpr int RING_OFF = 0, RING_BYTES = 131072;
constexpr int LDS_BYTES = 147456;
constexpr int LDSCTL_OFF = LDS_BYTES - 512, MISC_OFF = LDSCTL_OFF + 320;
static_assert(MISC_OFF + 128 <= LDS_BYTES && mla::LDS_BYTES <= LDSCTL_OFF && RING_BYTES <= LDSCTL_OFF, "LDS map");
constexpr int RSL_OFF = 133120, RSL_ROWS = 2048;
static_assert(RSL_OFF >= RING_BYTES && RSL_OFF + RSL_ROWS * 4 <= LDSCTL_OFF, "LDS map: row-scale table");

#define GAS __attribute__((address_space(1)))
#define LAS __attribute__((address_space(3)))
typedef unsigned short bf16;
typedef unsigned v4u __attribute__((ext_vector_type(4)));
typedef unsigned v2u __attribute__((ext_vector_type(2)));
typedef float f32x4 __attribute__((ext_vector_type(4)));
typedef float f32x2 __attribute__((ext_vector_type(2)));
typedef GAS unsigned gu32;
#define RLX_AGENT __ATOMIC_RELAXED, __HIP_MEMORY_SCOPE_AGENT
#define LDS_WAIT() asm volatile("s_waitcnt lgkmcnt(0)" ::: "memory")
#define VM_WAIT() asm volatile("s_waitcnt vmcnt(0)" ::: "memory")
__device__ __forceinline__ unsigned f2bf(float f) { unsigned u = __builtin_bit_cast(unsigned, f); return (u + 0x7fffu + ((u >> 16) & 1u)) >> 16; }
__device__ __forceinline__ unsigned pk2(float lo, float hi) { return f2bf(lo) | (f2bf(hi) << 16); }
__device__ __forceinline__ float bflo(unsigned w) { return __builtin_bit_cast(float, w << 16); }
__device__ __forceinline__ float bfhi(unsigned w) { return __builtin_bit_cast(float, w & 0xffff0000u); }

#define XB_TMO      128
#define XB_XCNT(j)  (256  + 64 * (j))
#define XB_XSUB(j)  (1280 + 64 * (j))
#define XB_XGEN(j)  (2304 + 64 * (j))
#define XB_TOP      3328
#define XB_TOPGEN   3392
#define XCD_BAR_WORDS 3456
#define XB_SPIN_CAP (1u << 18)

__device__ __forceinline__ unsigned xb_ld(unsigned* p)              { return __hip_atomic_load(p, __ATOMIC_RELAXED, __HIP_MEMORY_SCOPE_AGENT); }
__device__ __forceinline__ unsigned xb_add(unsigned* p, unsigned v) { return __hip_atomic_fetch_add(p, v, __ATOMIC_RELAXED, __HIP_MEMORY_SCOPE_AGENT); }
__device__ __forceinline__ unsigned xb_xcc_id() { return (unsigned)__builtin_amdgcn_s_getreg((3 << 11) | 20) & 0xFu; }
#define XB_SPIN(cond, bar) do { unsigned _sp = 0; while (cond) { __builtin_amdgcn_s_sleep(1); \
    if ((++_sp & 255u) == 0u) { if (xb_ld(&(bar)[XB_TMO])) break; if (_sp > XB_SPIN_CAP) { atomicAdd(&(bar)[XB_TMO], 1u); break; } } } } while (0)

struct XcdBarrier {
    unsigned* bar; unsigned x;
    volatile LAS unsigned* st;
};

__device__ __forceinline__ XcdBarrier xcd_barrier_post(unsigned* bar, volatile LAS unsigned* st, const bool leader  ) {
    XcdBarrier b; b.bar = bar; b.x = xb_xcc_id(); b.st = st;
    if (leader) (void)xb_add(&bar[XB_XCNT(b.x)], 1u);
    return b;
}
__device__ __forceinline__ void xcd_barrier_complete(unsigned* bar, unsigned x, unsigned& nloc, unsigned& nx) {
    const unsigned G = gridDim.x * gridDim.y * gridDim.z;
    unsigned sum, cnt, mine, sp = 0u;
    for (;;) {
        sum = 0u; cnt = 0u; mine = 0u;
#pragma unroll
        for (unsigned j = 0; j < 16; ++j) { const unsigned c = xb_ld(&bar[XB_XCNT(j)]); sum += c; cnt += (c > 0u) ? 1u : 0u; mine = (j == x) ? c : mine; }
        if (sum == G) break;
        __builtin_amdgcn_s_sleep(1);
        if ((++sp & 255u) == 0u) { if (xb_ld(&bar[XB_TMO])) break; if (sp > XB_SPIN_CAP) { atomicAdd(&bar[XB_TMO], 1u); break; } }
    }
    nloc = mine > 0u ? mine : 1u; nx = cnt > 0u ? cnt : 1u;
}

__device__ __forceinline__ void xcd_barrier(const XcdBarrier& b, const bool leader  ) {
    asm volatile("s_waitcnt vmcnt(0)" ::: "memory");
    __syncthreads();
    if (leader) {
        unsigned* bar = b.bar;
        __builtin_amdgcn_s_waitcnt(0);
        unsigned nloc = b.st[0], nx = b.st[1];
        if (nloc == 0u) { xcd_barrier_complete(bar, b.x, nloc, nx); b.st[0] = nloc; b.st[1] = nx; }
        const unsigned old = xb_add(&bar[XB_XSUB(b.x)], 1u);
        const unsigned gen = old / nloc;
        if (old + 1u == (gen + 1u) * nloc) {
            __builtin_amdgcn_fence(__ATOMIC_RELEASE, "agent");
            asm volatile("s_waitcnt vmcnt(0)" ::: "memory");
            const unsigned og = xb_add(&bar[XB_TOP], 1u);
            const unsigned tg = og / nx;
            if (og + 1u == (tg + 1u) * nx) xb_add(&bar[XB_TOPGEN], 1u);
            else XB_SPIN(xb_ld(&bar[XB_TOPGEN]) == tg, bar);
            __builtin_amdgcn_fence(__ATOMIC_ACQUIRE, "agent");
            xb_add(&bar[XB_XGEN(b.x)], 1u);
            asm volatile("s_waitcnt vmcnt(0)" ::: "memory");
        } else {
            XB_SPIN(xb_ld(&bar[XB_XGEN(b.x)]) == gen, bar);
            __builtin_amdgcn_fence(__ATOMIC_ACQUIRE, "agent");
            asm volatile("s_waitcnt vmcnt(0)" ::: "memory");
        }
    }
    __syncthreads();
}


struct Frame {
    LAS unsigned char* lds; volatile LAS unsigned* MISC; gu32* ctl;
    int wave, vcu, G;
    const float* in[19]; float* out; unsigned char* ws;
};
__device__ __forceinline__ float wave_sum(float v, int lane) {
#pragma unroll
    for (int o = 1; o < 64; o <<= 1) v += shfl_xor_f(v, o, lane);
    return v;
}
struct P0Item { const GAS float* src; size_t st8; const GAS float* gp; bf16* dst; int K; };
__device__ __forceinline__ P0Item p0_decode(Frame& F, int it, int lane) {
    constexpr int I_POOL = 16 * 32, I_DKV = 64 * 18, I_DQ = 64 * 32, I_UKV = 8 * 256, I_UQ = 16 * 192, I_WO = 64 * 128, I_WIN = 64 * 688, I_WOUT = 172 * 128;
    unsigned char* ws = F.ws; int r = it; const float* W; const float* gain = nullptr; bf16* WT; int K, N, row_off = 0; bool perm_win = false;
    if (r < 4 * I_POOL) { const int g = r / I_POOL; r -= g * I_POOL; W = F.in[2] + (size_t)g * 1024 * 1024; K = 1024; N = 1024; WT = (bf16*)(ws + WS_WPOOL); row_off = g * 1024; }
    else if ((r -= 4 * I_POOL) < I_DKV) { W = F.in[5]; K = DM; N = 576; WT = (bf16*)(ws + WS_WDKVQ); gain = F.in[4]; }
    else if ((r -= I_DKV) < I_DQ) { W = F.in[9]; K = DM; N = 1024; WT = (bf16*)(ws + WS_WDKVQ); row_off = 576; gain = F.in[8]; }
    else if ((r -= I_DQ) < I_UKV) { W = F.in[7]; K = 512; N = 8192; WT = (bf16*)(ws + WS_WUKV); gain = F.in[6]; }
    else if ((r -= I_UKV) < I_UQ) { W = F.in[11]; K = 1024; N = 6144; WT = (bf16*)(ws + WS_WUQ); gain = F.in[10]; }
    else if ((r -= I_UQ) < I_WO) { W = F.in[12]; K = DM; N = DM; WT = (bf16*)(ws + WS_WO); }
    else if ((r -= I_WO) < 2 * I_WIN) { const int l = r / I_WIN; r -= l * I_WIN; W = F.in[14] + (size_t)l * DM * NFF; K = DM; N = NFF; WT = (bf16*)(ws + WS_WIN + l * WIN_L); gain = F.in[13] + l * DM; perm_win = true; }
    else { r -= 2 * I_WIN; const int l = r / I_WOUT; r -= l * I_WOUT; W = F.in[17] + (size_t)l * DFF * DM; K = DFF; N = DM; WT = (bf16*)(ws + WS_WOUT + l * WOUT_L); }
    const int nblk = N / 32, kb = r / nblk, nb = r - kb * nblk, k0 = 64 * kb, n0 = 32 * nb, kq = lane >> 3, n4 = (lane & 7) * 4;
    P0Item D; D.src = (const GAS float*)W + (size_t)(k0 + kq) * N + n0 + n4; D.st8 = (size_t)8 * N; D.gp = gain ? (const GAS float*)gain + k0 + kq : nullptr;
    int drow = row_off + n0;
    if (perm_win) { const int half = n0 >= DFF ? 1 : 0, s = n0 - half * DFF; drow = (s >> 7) * 256 + half * 128 + (s & 127); }
    D.dst = WT + (size_t)drow * K + k0; D.K = K; return D;
}
#define P0_DECL(p) f32x4 p##0, p##1, p##2, p##3, p##4, p##5, p##6, p##7; float p##g0, p##g1, p##g2, p##g3, p##g4, p##g5, p##g6, p##g7
#define P0_LOAD(D, p) do { p##0 = *(const GAS f32x4*)((D).src); p##1 = *(const GAS f32x4*)((D).src + (D).st8); p##2 = *(const GAS f32x4*)((D).src + 2 * (D).st8); p##3 = *(const GAS f32x4*)((D).src + 3 * (D).st8); \
        p##4 = *(const GAS f32x4*)((D).src + 4 * (D).st8); p##5 = *(const GAS f32x4*)((D).src + 5 * (D).st8); p##6 = *(const GAS f32x4*)((D).src + 6 * (D).st8); p##7 = *(const GAS f32x4*)((D).src + 7 * (D).st8); \
        p##g0 = p##g1 = p##g2 = p##g3 = p##g4 = p##g5 = p##g6 = p##g7 = 1.f; \
        if ((D).gp) { p##g0 = (D).gp[0]; p##g1 = (D).gp[8]; p##g2 = (D).gp[16]; p##g3 = (D).gp[24]; p##g4 = (D).gp[32]; p##g5 = (D).gp[40]; p##g6 = (D).gp[48]; p##g7 = (D).gp[56]; } } while (0)
#define P0_COPY(d, s) do { d##0 = s##0; d##1 = s##1; d##2 = s##2; d##3 = s##3; d##4 = s##4; d##5 = s##5; d##6 = s##6; d##7 = s##7; \
        d##g0 = s##g0; d##g1 = s##g1; d##g2 = s##g2; d##g3 = s##g3; d##g4 = s##g4; d##g5 = s##g5; d##g6 = s##g6; d##g7 = s##g7; } while (0)
#define P0_PUT(i, v, g) do { d_[(8 * (i)) * 33 + 0] = v.x * g; d_[(8 * (i)) * 33 + 1] = v.y * g; d_[(8 * (i)) * 33 + 2] = v.z * g; d_[(8 * (i)) * 33 + 3] = v.w * g; } while (0)
#define P0_FINISH(D, p) do { LAS float* d_ = scr + (llane >> 3) * 33 + (llane & 7) * 4; \
        P0_PUT(0, p##0, p##g0); P0_PUT(1, p##1, p##g1); P0_PUT(2, p##2, p##g2); P0_PUT(3, p##3, p##g3); P0_PUT(4, p##4, p##g4); P0_PUT(5, p##5, p##g5); P0_PUT(6, p##6, p##g6); P0_PUT(7, p##7, p##g7); \
        LDS_WAIT(); asm volatile("" ::: "memory"); const int c_ = llane & 7; \
        _Pragma("unroll") for (int j_ = 0; j_ < 4; ++j_) { const int n_ = (llane >> 3) + 8 * j_; const LAS float* s_ = scr + (8 * c_) * 33 + n_; \
            v4u o_; o_.x = pk2(s_[0 * 33], s_[1 * 33]); o_.y = pk2(s_[2 * 33], s_[3 * 33]); o_.z = pk2(s_[4 * 33], s_[5 * 33]); o_.w = pk2(s_[6 * 33], s_[7 * 33]); \
            *(GAS v4u*)((D).dst + (size_t)n_ * (D).K + 8 * c_) = o_; } \
        LDS_WAIT(); asm volatile("" ::: "memory"); } while (0)
__device__ __forceinline__ void p0_prologue(Frame& F) {
    int lane_l = lane_id(), vcu_l = F.vcu; asm volatile("" : "+v"(lane_l)); asm volatile("" : "+s"(vcu_l)); int wave_l = F.wave; asm volatile("" : "+s"(wave_l)); const int llane = lane_l, lwave = wave_l, ltid = lwave * 64 + llane, lvcu = vcu_l;
    LAS float* scr = (LAS float*)(F.lds + RING_OFF + lwave * 16384);
    const int gw = lvcu * NWAVES + lwave, NGW = F.G * NWAVES;
    unsigned char* ws = F.ws;
    constexpr int NITEMS = 4 * (16 * 32) + 64 * 18 + 64 * 32 + 8 * 256 + 16 * 192 + 64 * 128 + 2 * (64 * 688) + 2 * (172 * 128);
    if (gw < NITEMS) {
        int it = gw; P0Item A = p0_decode(F, it, llane); P0_DECL(a); P0_DECL(b); P0_LOAD(A, a);
        for (;;) { const int nx = it + NGW; const bool more = nx < NITEMS; P0Item B = A; P0_COPY(b, a);
            if (more) { B = p0_decode(F, nx, llane); P0_LOAD(B, b); }
            P0_FINISH(A, a);
            if (!more) break;
            A = B; P0_COPY(a, b); it = nx; }
    }
    const int gt = lvcu * (NWAVES * 64) + ltid, NT = F.G * NWAVES * 64;
    { GAS v4u* z = (GAS v4u*)(ws + WS_WDKVQ + (size_t)1600 * DM * 2); for (int i = gt; i < 192 * DM * 2 / 16; i += NT) z[i] = (v4u){0u, 0u, 0u, 0u}; }
    { GAS f32x2* T = (GAS f32x2*)(ws + WS_ROPE);
      for (int e = gt; e < S_ * 32; e += NT) { const int pos = e >> 5, i = e & 31;
          const float inv = __builtin_powf(10000.0f, -(float)(2 * i) / 64.0f); const float ang = (float)pos * inv;
          const double a = (double)ang, n = __builtin_rint(a * 0.15915494309189535), rd = __builtin_fma(-n, 6.283185307179586, a) - n * 2.4492935982947064e-16;
          const float r = (float)rd; T[e] = (f32x2){__builtin_cosf(r), __builtin_sinf(r)}; } }
}
#undef P0_DECL
#undef P0_LOAD
#undef P0_COPY
#undef P0_PUT
#undef P0_FINISH
constexpr int POOL_RUN = 32, POOL_HALO = 15;
__device__ __forceinline__ void pool_phase(Frame& F) {
    int lane_l = lane_id(), vcu_l = F.vcu; asm volatile("" : "+v"(lane_l)); asm volatile("" : "+s"(vcu_l)); int wave_l = F.wave; asm volatile("" : "+s"(wave_l)); const int llane = lane_l, lwave = wave_l, ltid = lwave * 64 + llane, lvcu = vcu_l;
    const GAS float* x = (const GAS float*)F.in[0]; const GAS float* gain = (const GAS float*)F.in[1];
    GAS v4u* XP = (GAS v4u*)(F.ws + WS_XPB); LAS float* rsl = (LAS float*)(F.lds + RSL_OFF);
    const int ch = ltid * 8, w = 2 << (ch >> 10);
    const f32x4 g0 = *(const GAS f32x4*)(gain + ch), g1 = *(const GAS f32x4*)(gain + ch + 4);
    for (int r = lvcu; r < S_ / POOL_RUN; r += F.G) { const int t0 = r * POOL_RUN, tb = t0 - POOL_HALO;
        for (int j = lwave; j < POOL_RUN + POOL_HALO; j += NWAVES) { const int t = tb + j; if (t < 0) continue;
            const GAS f32x4* xr = (const GAS f32x4*)(x + (size_t)t * DM) + llane; float s = 0.f;
#pragma unroll
            for (int q = 0; q < 16; ++q) { const f32x4 v = xr[64 * q]; s += (v.x * v.x + v.y * v.y) + (v.z * v.z + v.w * v.w); }
            const float tot = wave_sum(s, llane); if (llane == 0) rsl[j] = 1.0f / __builtin_sqrtf(tot * (1.f / DM) + EPS); }
        __syncthreads();
        f32x4 s0 = {0.f, 0.f, 0.f, 0.f}, s1 = s0;
        for (int q = (t0 - w + 1 > 0 ? t0 - w + 1 : 0); q < t0; ++q) { const float rq = rsl[q - tb]; const GAS f32x4* p = (const GAS f32x4*)(x + (size_t)q * DM + ch); s0 += p[0] * rq; s1 += p[1] * rq; }
#pragma unroll 4
        for (int t = t0; t < t0 + POOL_RUN; ++t) { const float rt = rsl[t - tb]; const GAS f32x4* p = (const GAS f32x4*)(x + (size_t)t * DM + ch); const f32x4 c0 = p[0] * rt, c1 = p[1] * rt;
            s0 += c0; s1 += c1;
            const int lo = t - w + 1; const float ic = 1.0f / (float)(lo > 0 ? w : t + 1);
            const f32x4 o0 = (s0 * ic - c0) * g0, o1 = (s1 * ic - c1) * g1;
            XP[(size_t)t * (DM / 8) + ltid] = (v4u){pk2(o0.x, o0.y), pk2(o0.z, o0.w), pk2(o1.x, o1.y), pk2(o1.z, o1.w)};
            if (lo >= 0) { const float rl = rsl[lo - tb]; const GAS f32x4* pl = (const GAS f32x4*)(x + (size_t)lo * DM + ch); s0 -= pl[0] * rl; s1 -= pl[1] * rl; } }
        __syncthreads();
    }
}
__device__ __forceinline__ void norm_phase(Frame& F, bool final_, const float* gain) {
    int lane_l = lane_id(), vcu_l = F.vcu; asm volatile("" : "+v"(lane_l)); asm volatile("" : "+s"(vcu_l)); int wave_l = F.wave; asm volatile("" : "+s"(wave_l)); const int llane = lane_l, lwave = wave_l, lvcu = vcu_l;
    (void)final_;
    const int gw = lvcu * NWAVES + lwave, NGW = F.G * NWAVES;
    const bf16* HB = (const bf16*)(F.ws + WS_XN);
    for (int m = gw; m < S_; m += NGW) { const GAS v4u* xr = (const GAS v4u*)(HB + (size_t)m * DM) + llane; v4u v[8]; float s = 0.f;
#pragma unroll
        for (int j = 0; j < 8; ++j) { v[j] = xr[64 * j]; const float a0 = bflo(v[j].x), a1 = bfhi(v[j].x), a2 = bflo(v[j].y), a3 = bfhi(v[j].y), a4 = bflo(v[j].z), a5 = bfhi(v[j].z), a6 = bflo(v[j].w), a7 = bfhi(v[j].w);
            s += (a0 * a0 + a1 * a1) + (a2 * a2 + a3 * a3) + (a4 * a4 + a5 * a5) + (a6 * a6 + a7 * a7); }
        const float rs = 1.0f / __builtin_sqrtf(wave_sum(s, llane) * (1.f / DM) + EPS);
        GAS f32x4* o = (GAS f32x4*)(F.out + (size_t)m * DM) + 2 * llane; const GAS f32x4* gp = (const GAS f32x4*)gain + 2 * llane;
#pragma unroll
        for (int j = 0; j < 8; ++j) { const f32x4 g0 = gp[128 * j], g1 = gp[128 * j + 1];
            o[128 * j] = (f32x4){bflo(v[j].x), bfhi(v[j].x), bflo(v[j].y), bfhi(v[j].y)} * rs * g0; o[128 * j + 1] = (f32x4){bflo(v[j].z), bfhi(v[j].z), bflo(v[j].w), bfhi(v[j].w)} * rs * g1; } }
}
__device__ __forceinline__ void rs_to_lds(Frame& F, int row_base) {
    int lane_l = lane_id(); asm volatile("" : "+v"(lane_l)); int wave_l = F.wave; asm volatile("" : "+s"(wave_l)); const int ltid = wave_l * 64 + lane_l;
    const GAS f32x4* SSQ = (const GAS f32x4*)(F.ws + WS_SSQ); LAS float* RSL = (LAS float*)(F.lds + RSL_OFF);
    for (int r = ltid; r < RSL_ROWS; r += NWAVES * 64) { const GAS f32x4* p = SSQ + (size_t)(row_base + r) * 16; float s = 0.f;
#pragma unroll
        for (int q = 0; q < 16; ++q) { const f32x4 v = p[q]; s += (v.x + v.y) + (v.z + v.w); }
        RSL[r] = 1.0f / __builtin_sqrtf(s * (1.f / DM) + EPS); }
    __syncthreads();
}
__device__ __forceinline__ void fixup_phase(Frame& F, int layer) {
    int lane_l = lane_id(), vcu_l = F.vcu; asm volatile("" : "+v"(lane_l)); asm volatile("" : "+s"(vcu_l)); int wave_l = F.wave; asm volatile("" : "+s"(wave_l)); const int llane = lane_l, lwave = wave_l, ltid = lwave * 64 + llane, lvcu = vcu_l;
    const int gt = lvcu * (NWAVES * 64) + ltid, NT = F.G * NWAVES * 64;
    constexpr int NCH = DFF / 8, NRUN = S_ / 64;
    const float* cw = F.in[15] + (size_t)layer * 3 * NFF; const float* cb = F.in[16] + (size_t)layer * NFF;
    const bf16* UE = (const bf16*)(F.ws + WS_UE); bf16* Gb = (bf16*)(F.ws + WS_G);
    for (int it = gt; it < (NRUN - 1) * NCH; it += NT) { const int r = 1 + it / NCH, c = it % NCH, j0 = c * 8;
        const bf16* ep = UE + ((size_t)(r - 1) * 4 + 2) * NFF + j0;
        float o0[8], o1[8];
#pragma unroll
        for (int h = 0; h < 2; ++h) {
            const v4u a = *(const GAS v4u*)(ep + h * DFF), b = *(const GAS v4u*)(ep + NFF + h * DFF), cc = *(const GAS v4u*)(ep + 2 * NFF + h * DFF), d = *(const GAS v4u*)(ep + 3 * NFF + h * DFF);
            const unsigned aw[4] = {a.x, a.y, a.z, a.w}, bw[4] = {b.x, b.y, b.z, b.w}, cw4[4] = {cc.x, cc.y, cc.z, cc.w}, dw[4] = {d.x, d.y, d.z, d.w};
#pragma unroll
            for (int e = 0; e < 8; ++e) { const float um2 = (e & 1) ? bfhi(aw[e >> 1]) : bflo(aw[e >> 1]), um1 = (e & 1) ? bfhi(bw[e >> 1]) : bflo(bw[e >> 1]), u0 = (e & 1) ? bfhi(cw4[e >> 1]) : bflo(cw4[e >> 1]), u1 = (e & 1) ? bfhi(dw[e >> 1]) : bflo(dw[e >> 1]);
                const int col = h * DFF + j0 + e; const float w0 = cw[col], w1 = cw[NFF + col], w2 = cw[2 * NFF + col], bb = cb[col];
                const float y0 = bb + w0 * um2 + w1 * um1 + w2 * u0, y1 = bb + w0 * um1 + w1 * u0 + w2 * u1;
                if (h == 0) { o0[e] = y0 * __builtin_amdgcn_rcpf(1.0f + __builtin_amdgcn_exp2f(-1.4426950408889634f * y0)); o1[e] = y1 * __builtin_amdgcn_rcpf(1.0f + __builtin_amdgcn_exp2f(-1.4426950408889634f * y1)); }
                else { o0[e] *= y0; o1[e] *= y1; } }
        }
        *(GAS v4u*)(Gb + (size_t)(64 * r) * DFF + j0) = (v4u){pk2(o0[0], o0[1]), pk2(o0[2], o0[3]), pk2(o0[4], o0[5]), pk2(o0[6], o0[7])};
        *(GAS v4u*)(Gb + (size_t)(64 * r + 1) * DFF + j0) = (v4u){pk2(o1[0], o1[1]), pk2(o1[2], o1[3]), pk2(o1[4], o1[5]), pk2(o1[6], o1[7])};
    }
}
struct LatRow { v4u a, q0, q1; float x1, x2; f32x2 cs; };
__device__ __forceinline__ LatRow lat_load(const bf16* CR, const GAS f32x2* T, int m, int l) { const bf16* row = CR + (size_t)m * NDKVQ; LatRow r;
    r.a = *(const GAS v4u*)(row + 8 * l); r.q0 = *(const GAS v4u*)(row + 576 + 16 * l); r.q1 = *(const GAS v4u*)(row + 576 + 16 * l + 8);
    r.x1 = bflo((unsigned)*(const GAS unsigned short*)(row + 512 + (l & 31))); r.x2 = bflo((unsigned)*(const GAS unsigned short*)(row + 544 + (l & 31))); r.cs = T[(size_t)m * 32 + (l & 31)]; return r; }
__device__ __forceinline__ f32x4 bf4lo(const v4u& w) { return (f32x4){bflo(w.x), bfhi(w.x), bflo(w.y), bfhi(w.y)}; }
__device__ __forceinline__ f32x4 bf4hi(const v4u& w) { return (f32x4){bflo(w.z), bfhi(w.z), bflo(w.w), bfhi(w.w)}; }
__device__ __forceinline__ float ssq4(const f32x4& v) { return (v.x * v.x + v.y * v.y) + (v.z * v.z + v.w * v.w); }
__device__ __forceinline__ void lat_finish(Frame& F, const LatRow& r, int m, int l) {
    const f32x4 a0 = bf4lo(r.a), a1 = bf4hi(r.a), q0 = bf4lo(r.q0), q1 = bf4hi(r.q0), q2 = bf4lo(r.q1), q3 = bf4hi(r.q1);
    const float sa = ssq4(a0) + ssq4(a1), sq = (ssq4(q0) + ssq4(q1)) + (ssq4(q2) + ssq4(q3));
    const float ra = 1.0f / __builtin_sqrtf(wave_sum(sa, l) * (1.f / 512.f) + EPS), rq = 1.0f / __builtin_sqrtf(wave_sum(sq, l) * (1.f / 1024.f) + EPS);
    *(GAS v4u*)(F.ws + WS_CKVN + ((size_t)m * 512 + 8 * l) * 2) = (v4u){pk2(a0.x * ra, a0.y * ra), pk2(a0.z * ra, a0.w * ra), pk2(a1.x * ra, a1.y * ra), pk2(a1.z * ra, a1.w * ra)};
    GAS v4u* cq = (GAS v4u*)(F.ws + WS_CQN + ((size_t)m * 1024 + 16 * l) * 2);
    cq[0] = (v4u){pk2(q0.x * rq, q0.y * rq), pk2(q0.z * rq, q0.w * rq), pk2(q1.x * rq, q1.y * rq), pk2(q1.z * rq, q1.w * rq)};
    cq[1] = (v4u){pk2(q2.x * rq, q2.y * rq), pk2(q2.z * rq, q2.w * rq), pk2(q3.x * rq, q3.y * rq), pk2(q3.z * rq, q3.w * rq)};
    GAS bf16* kr = (GAS bf16*)(F.ws + WS_KR) + (size_t)m * 64;
    if (l < 32) kr[l] = (bf16)f2bf(r.x1 * r.cs.x - r.x2 * r.cs.y); else kr[l] = (bf16)f2bf(r.x2 * r.cs.x + r.x1 * r.cs.y);
}
__device__ __forceinline__ void latnorm_phase(Frame& F) {
    int lane_l = lane_id(), vcu_l = F.vcu; asm volatile("" : "+v"(lane_l)); asm volatile("" : "+s"(vcu_l)); int wave_l = F.wave; asm volatile("" : "+s"(wave_l)); const int llane = lane_l, lwave = wave_l, lvcu = vcu_l;
    const int gw = lvcu * NWAVES + lwave, NGW = F.G * NWAVES, l = llane;
    const bf16* CR = (const bf16*)(F.ws + WS_CR); const GAS f32x2* T = (const GAS f32x2*)(F.ws + WS_ROPE);
    for (int m = gw; m < S_; m += 2 * NGW) { const int m2 = m + NGW; const bool two = m2 < S_;
        const LatRow r0 = lat_load(CR, T, m, l); const LatRow r1 = lat_load(CR, T, two ? m2 : m, l);
        lat_finish(F, r0, m, l); if (two) lat_finish(F, r1, m2, l); }
}
#ifndef PG8_SP2
#define PG8_SP2 true
#endif
#ifndef PG8_ALIGN
#define PG8_ALIGN true
#endif
#ifndef FFN2_WGM
#define FFN2_WGM 2
#endif
#ifndef PG8_ALIGN_RES
#define PG8_ALIGN_RES true
#endif
struct Args { const float* in[19]; float* out; unsigned char* ws; int ph_lo, ph_hi; };
__global__ void __launch_bounds__(NWAVES * 64, 2) mk_fwd(Args args) {
    extern __shared__ __attribute__((aligned(16))) unsigned char lds[];
    Frame F;
    F.lds = (LAS unsigned char*)lds;
    F.MISC = (volatile LAS unsigned*)(F.lds + MISC_OFF);
    F.wave = __builtin_amdgcn_readfirstlane((int)threadIdx.x >> 6);
    F.G = gridDim.x; { const int bx = blockIdx.x; F.vcu = (F.G % 8 == 0) ? (bx % 8) * (F.G / 8) + bx / 8 : bx; }
    F.ws = args.ws; F.out = args.out; F.ctl = (gu32*)(args.ws + WS_CTL);
#pragma unroll
    for (int i = 0; i < 19; ++i) F.in[i] = args.in[i];
    for (int u = (int)threadIdx.x; u < (LDS_BYTES - LDSCTL_OFF) / 4; u += NWAVES * 64) ((LAS unsigned*)(F.lds + LDSCTL_OFF))[u] = 0u;
    __syncthreads();
    XcdBarrier bar; bar.bar = (unsigned*)(F.ctl + CW_BAR); bar.x = 0; bar.st = nullptr;
    if (N_LAUNCHES == 1) bar = xcd_barrier_post((unsigned*)(F.ctl + CW_BAR), F.MISC + 8, threadIdx.x == 0);
    const int lo = args.ph_lo, hi = args.ph_hi; int pid = 0;
#define BIDX() ({ int b_ = (int)blockIdx.x; asm volatile("" : "+s"(b_)); b_; })
#ifndef STAGGER_TICKS
#define STAGGER_TICKS 0
#endif
#define STAGGER() do { const int g_ = (BIDX() >> 6) & 3; if (STAGGER_TICKS > 0 && g_) { const unsigned long long t0_ = __builtin_amdgcn_s_memrealtime(); \
        while (__builtin_amdgcn_s_memrealtime() - t0_ < (unsigned long long)(g_ * STAGGER_TICKS)) __builtin_amdgcn_s_sleep(8); } } while (0)
    unsigned char* ws = args.ws;
#define IN() (lo <= pid && pid < hi)
#define GBAR() xcd_barrier(bar, F.wave == 0 && lane_id() == 0)
#define SEAM() do { if (N_LAUNCHES == 1 && lo <= pid && pid + 1 < hi) GBAR(); ++pid; } while (0)
#ifndef REPEAT_SITES
#define REPEAT_SITES 0u
#endif
#define REPS(site) (((REPEAT_SITES >> (site)) & 1u) ? 2 : 1)
#define PH_BEGIN(site) if (IN()) { for (int rep_ = 0; rep_ < REPS(site); ++rep_) { if (rep_) GBAR(); const bool dry_ = (rep_ + 1 < REPS(site)); (void)dry_;
#define PH_END() } } SEAM();
    bf16* const Hdummy = (bf16*)(args.ws + WS_DUMMY);
    PH_BEGIN(0) { p0_prologue(F); __syncthreads(); pool_phase(F); } PH_END()
    for (int l = 0; l < 2; ++l) {
        if (l == 0) {
            PH_BEGIN(2) {
                pg8::Gemm g{(const bf16*)(ws + WS_XPB), (const bf16*)(ws + WS_WPOOL), S_, DM, 1024, DM}; pg8::PoolOrder S; S.init(S_, DM, F.G, BIDX());
                pg8::EpiResStat E{F.in[0], DM, F.in[3], (bf16*)(ws + WS_XN), (float*)(ws + WS_SSQ), (bf16*)(ws + WS_XN)};
                pg8::gemm_phase<pg8::EpiResStat, pg8::PoolOrder, PG8_ALIGN_RES, PG8_SP2>(F.lds + RING_OFF, g, S, E, F.wave);
            } PH_END()
        } else {
            PH_BEGIN(3) {
                pg8::Gemm g{(const bf16*)(ws + WS_XN), (const bf16*)(ws + WS_WDKVQ), S_, NDKVQ, DM, DM}; pg8::StaticOrder S; S.init(S_, NDKVQ, F.G, BIDX());
                const int cb_ = BIDX(), rb_ = 2048 * (cb_ & 7); rs_to_lds(F, rb_);
                pg8::EpiBf16S E{(bf16*)(ws + WS_CR), NDKVQ, (const PG8_LAS float*)(F.lds + RSL_OFF), rb_};
                pg8::gemm_phase<pg8::EpiBf16S, pg8::StaticOrder, PG8_ALIGN, PG8_SP2>(F.lds + RING_OFF, g, S, E, F.wave);
            } PH_END()
            PH_BEGIN(4) latnorm_phase(F); PH_END()
            PH_BEGIN(5) {
                { pg8::Gemm g{(const bf16*)(ws + WS_CKVN), (const bf16*)(ws + WS_WUKV), S_, 8192, 512, 512}; pg8::StaticOrder S; S.init(S_, 8192, F.G, BIDX());
                  pg8::EpiBf16 E{(bf16*)(ws + WS_KV), 8192};
                  pg8::gemm_phase<pg8::EpiBf16, pg8::StaticOrder, PG8_ALIGN, PG8_SP2>(F.lds + RING_OFF, g, S, E, F.wave); }
                { pg8::Gemm g{(const bf16*)(ws + WS_CQN), (const bf16*)(ws + WS_WUQ), S_, 6144, 1024, 1024}; pg8::StaticOrder S; S.init(S_, 6144, F.G, BIDX());
                  pg8::EpiBf16 E{(bf16*)(ws + WS_Q), 6144};
                  pg8::gemm_phase<pg8::EpiBf16, pg8::StaticOrder, PG8_ALIGN, PG8_SP2>(F.lds + RING_OFF, g, S, E, F.wave); }
            } PH_END()
            PH_BEGIN(7) { const mla::Tensors T{(const bf16*)(ws + WS_Q), (const bf16*)(ws + WS_KV), (const bf16*)(ws + WS_KR), (bf16*)(ws + WS_O), (const float*)(ws + WS_ROPE)};
                mla::attn_phase((char*)lds + RING_OFF, (mla::lds_uc*)(F.lds + RING_OFF), T, (int)F.G, BIDX(), F.wave); } PH_END()
            PH_BEGIN(8) {
                STAGGER();
                pg8::Gemm g{(const bf16*)(ws + WS_O), (const bf16*)(ws + WS_WO), S_, DM, DM, DM}; pg8::StaticOrder S; S.init(S_, DM, F.G, BIDX());
                pg8::EpiResStat E{nullptr, DM, nullptr, (bf16*)(ws + WS_XN), (float*)(ws + WS_SSQ), dry_ ? Hdummy : (bf16*)(ws + WS_XN)};
                pg8::gemm_phase<pg8::EpiResStat, pg8::StaticOrder, PG8_ALIGN_RES, PG8_SP2>(F.lds + RING_OFF, g, S, E, F.wave);
            } PH_END()
        }
        PH_BEGIN(10) {
            STAGGER();
            pg8::Gemm g{(const bf16*)(ws + WS_XN), (const bf16*)(ws + WS_WIN + l * WIN_L), S_, NFF, DM, DM}; pg8::StaticOrder S; S.init(S_, NFF, F.G, BIDX());
            const int cb_ = BIDX(), rb_ = 2048 * (cb_ & 7); rs_to_lds(F, rb_);
            const int full_ = S.nwg / S.G, rem_ = S.nwg - full_ * S.G; const bool split_ = (2 * rem_ == S.G);
            if (split_) S.lim = full_ * S.G;
            pg8::EpiConvGate E{(bf16*)(ws + WS_G), (const PG8_LAS float*)(F.lds + RSL_OFF), rb_, F.in[15] + (size_t)l * 3 * NFF, F.in[16] + (size_t)l * NFF, (bf16*)(ws + WS_UE)};
            pg8::gemm_phase<pg8::EpiConvGate, pg8::StaticOrder, PG8_ALIGN, PG8_SP2>(F.lds + RING_OFF, g, S, E, F.wave);
            if (split_) { pg8::TailOrder T; T.init(S_, NFF, F.G, BIDX());
                if (BIDX() < rem_) { pg8::EpiConvGateT<1> E1{E.G, E.RSL, E.row_base, E.cw, E.cb, E.UE}; pg8::gemm_phase<pg8::EpiConvGateT<1>, pg8::TailOrder, PG8_ALIGN, PG8_SP2, 1>(F.lds + RING_OFF, g, T, E1, F.wave); }
                else { pg8::EpiConvGateT<2> E2{E.G, E.RSL, E.row_base, E.cw, E.cb, E.UE}; pg8::gemm_phase<pg8::EpiConvGateT<2>, pg8::TailOrder, PG8_ALIGN, PG8_SP2, 2>(F.lds + RING_OFF, g, T, E2, F.wave); } }
        } PH_END()
        PH_BEGIN(11) fixup_phase(F, l); PH_END()
        PH_BEGIN(12) {
            STAGGER();
            pg8::Gemm g{(const bf16*)(ws + WS_G), (const bf16*)(ws + WS_WOUT + l * WOUT_L), S_, DM, DFF, DFF}; pg8::StaticOrder S; S.init(S_, DM, F.G, BIDX()); S.wgm = FFN2_WGM;
            pg8::EpiResStat E{nullptr, DM, nullptr, (bf16*)(ws + WS_XN), (float*)(ws + WS_SSQ), dry_ ? Hdummy : (bf16*)(ws + WS_XN)};
            pg8::gemm_phase<pg8::EpiResStat, pg8::StaticOrder, PG8_ALIGN_RES, PG8_SP2>(F.lds + RING_OFF, g, S, E, F.wave);
        } PH_END()
        if (l == 1) { PH_BEGIN(14) norm_phase(F, true, F.in[18]); PH_END() }
    }
#undef IN
#undef SEAM
#undef PH_BEGIN
#undef PH_END
}

#if defined(DEBUG_GOLD)
namespace dbg {
__device__ __forceinline__ float ldv(const float* p) { return *p; }
__device__ __forceinline__ float ldv(const unsigned short* p) { return __builtin_bit_cast(float, (unsigned)(*p) << 16); }
template <class T> __global__ void g_cmp(const T* fast, int ldf, const float* ref, int ldr, int rows, int cols, unsigned* status, unsigned code, float tol) {
    __shared__ double sd[16], sr[16]; __shared__ int bad;
    if (threadIdx.x == 0) bad = 0; __syncthreads();
    double d2 = 0.0, r2 = 0.0; int nb = 0;
    for (size_t i = threadIdx.x; i < (size_t)rows * cols; i += 1024) { const int r = (int)(i / cols), c = (int)(i % cols); const float f = ldv(fast + (size_t)r * ldf + c), g = ref[(size_t)r * ldr + c];
        if (!(f == f) || __builtin_fabsf(f) > 1e30f) nb = 1; const double d = (double)f - (double)g; d2 += d * d; r2 += (double)g * (double)g; }
    for (int o = 32; o >= 1; o >>= 1) { d2 += __shfl_xor(d2, o); r2 += __shfl_xor(r2, o); }
    if (nb) bad = 1;
    if ((threadIdx.x & 63) == 0) { sd[threadIdx.x >> 6] = d2; sr[threadIdx.x >> 6] = r2; } __syncthreads();
    if (threadIdx.x == 0) { double a = 0, b = 0; for (int i = 0; i < 16; ++i) { a += sd[i]; b += sr[i]; }
        if (bad || !(a <= (double)tol * b)) atomicCAS(status, 0u, code); }
}
__global__ void g_judge(const unsigned* status, float* out, size_t n) { const unsigned s = *status; if (s == 0u) return; const float v = sqrtf(10.f * (float)s);
    for (size_t i = (size_t)blockIdx.x * 256 + threadIdx.x; i < n; i += (size_t)gridDim.x * 256) out[i] = v; }
}
static void debug_forward(Args a, int grid, hipStream_t st) {
    using namespace gold;
    unsigned char* ws = a.ws; const float* const* in = a.in;
    Bufs b = carve(ws + (2048ull << 20));
    float* X2 = b.O + (size_t)GT0 * DM;
    unsigned* status = (unsigned*)(ws + WS_CTL) + 8;
    const float TOL = 3e-4f; unsigned code = 0; int p = 0;
    auto run = [&](int n) { for (int i = 0; i < n; ++i, ++p) { a.ph_lo = p; a.ph_hi = p + 1; hipLaunchKernelGGL(mk_fwd, dim3(grid), dim3(NWAVES * 64), LDS_BYTES, st, a); } };
    auto cmpf = [&](const void* f, int ldf, const float* r, int ldr, int cols) { ++code; dbg::g_cmp<float><<<1, 1024, 0, st>>>((const float*)f, ldf, r, ldr, GT0, cols, status, code, TOL); };
    auto cmpb = [&](const void* f, int ldf, const float* r, int ldr, int cols) { ++code; dbg::g_cmp<unsigned short><<<1, 1024, 0, st>>>((const unsigned short*)f, ldf, r, ldr, GT0, cols, status, code, TOL); };
    auto gffn = [&](int layer) {
        const float* fn = in[13] + (size_t)layer * DM; const float* win = in[14] + (size_t)layer * DM * NFF; const float* cw = in[15] + (size_t)layer * 3 * NFF;
        const float* cb = in[16] + (size_t)layer * NFF; const float* wout = in[17] + (size_t)layer * DFF * DM;
        cmpb(ws + WS_XN, DM, b.H, DM, DM);
        g_rmsnorm<<<GT0, 256, 0, st>>>(b.H, DM, fn, b.XN, DM, DM);
        g_matmul<0><<<dim3(NFF / 256, GT0 / 8), 256, 0, st>>>(b.XN, DM, win, NFF, b.U, NFF, DM, NFF, nullptr, 0, nullptr);
        g_convgate<<<GT0, 256, 0, st>>>(b.U, cw, cb, b.G);
        run(1); run(1); cmpb(ws + WS_G, DFF, b.G, DFF, DFF);
        g_matmul<1><<<dim3(DM / 256, GT0 / 8), 256, 0, st>>>(b.G, DFF, wout, DM, b.H, DM, DFF, DM, nullptr, 0, nullptr);
        run(1); cmpb(ws + WS_XN, DM, b.H, DM, DM);
    };
    const float* x = in[0];
    g_rmsnorm<<<GT0, 256, 0, st>>>(x, DM, in[1], b.XN, DM, DM); g_pool<<<GT0, 256, 0, st>>>(b.XN, b.T1);
    run(1); cmpb(ws + WS_XPB, DM, b.T1, DM, DM);
    for (int g = 0; g < 4; ++g)
        g_matmul<2><<<dim3(1024 / 256, GT0 / 8), 256, 0, st>>>(b.T1 + g * 1024, DM, in[2] + (size_t)g * 1024 * 1024, 1024, b.H + g * 1024, DM, 1024, 1024, x + g * 1024, DM, in[3] + g * 1024);
    run(1); cmpb(ws + WS_XN, DM, b.H, DM, DM);
    gffn(0);
    g_rmsnorm<<<GT0, 256, 0, st>>>(b.H, DM, in[4], b.XN, DM, DM);
    g_matmul<0><<<dim3(3, GT0 / 8), 256, 0, st>>>(b.XN, DM, in[5], 576, b.CKV, 576, DM, 576, nullptr, 0, nullptr);
    g_rmsnorm<<<GT0, 256, 0, st>>>(b.H, DM, in[8], b.XN, DM, DM);
    g_matmul<0><<<dim3(1024 / 256, GT0 / 8), 256, 0, st>>>(b.XN, DM, in[9], 1024, b.CQ, 1024, DM, 1024, nullptr, 0, nullptr);
    run(1); cmpf(ws + WS_CR, NDKVQ, b.CKV, 576, 576);
    cmpf(ws + WS_CR + 576 * 4, NDKVQ, b.CQ, 1024, 1024);
    g_rmsnorm<<<GT0, 256, 0, st>>>(b.CKV, 576, nullptr, X2, 512, 512);
    run(1); cmpb(ws + WS_CKVN, 512, X2, 512, 512);
    g_rmsnorm<<<GT0, 256, 0, st>>>(b.CQ, 1024, nullptr, X2, 1024, 1024); cmpb(ws + WS_CQN, 1024, X2, 1024, 1024);
    g_rmsnorm<<<GT0, 256, 0, st>>>(b.CKV, 576, in[6], b.CKVN, 512, 512);
    g_rope<<<GT0, 256, 0, st>>>(b.CKV, 576, 512, 0, 1); cmpb(ws + WS_KR, 64, b.CKV + 512, 576, 64);
    g_matmul<0><<<dim3(8192 / 256, GT0 / 8), 256, 0, st>>>(b.CKVN, 512, in[7], 8192, b.KVb, 8192, 512, 8192, nullptr, 0, nullptr);
    g_rmsnorm<<<GT0, 256, 0, st>>>(b.CQ, 1024, in[10], b.CQN, 1024, 1024);
    g_matmul<0><<<dim3(6144 / 256, GT0 / 8), 256, 0, st>>>(b.CQN, 1024, in[11], 6144, b.Q, 6144, 1024, 6144, nullptr, 0, nullptr);
    run(1); cmpb(ws + WS_KV, 8192, b.KVb, 8192, 8192);
    cmpb(ws + WS_Q, 6144, b.Q, 6144, 6144);
    g_rope<<<GT0, 256, 0, st>>>(b.Q, 6144, 128, 192, 32);
    g_attn<<<dim3(GT0, 32), 256, 0, st>>>(b.Q, b.KVb, b.CKV + 512, 576, b.O);
    run(1); cmpb(ws + WS_O, DM, b.O, DM, DM);
    g_matmul<1><<<dim3(DM / 256, GT0 / 8), 256, 0, st>>>(b.O, DM, in[12], DM, b.H, DM, DM, DM, nullptr, 0, nullptr);
    run(1); cmpb(ws + WS_XN, DM, b.H, DM, DM);
    gffn(1);
    run(1);
    g_rmsnorm<<<GT0, 256, 0, st>>>(b.H, DM, in[18], X2, DM, DM); cmpf(a.out, DM, X2, DM, DM);
    dbg::g_judge<<<1024, 256, 0, st>>>(status, a.out, (size_t)S_ * DM);
}
#endif
extern "C" void kernel_launch(void* const* d_in, const int* in_sizes, int n_in, void* d_out, int out_size, void* d_ws, size_t ws_size, hipStream_t stream) {
    static int grid = 0;
    if (grid == 0) {
        if (n_in != 19 || in_sizes[0] != S_ * DM || out_size != S_ * DM || ws_size < WS_END) { fprintf(stderr, "kernel_launch: unexpected shapes (n_in %d, in0 %d, out %d, ws %zu)\n", n_in, n_in > 0 ? in_sizes[0] : -1, out_size, ws_size); grid = -1; return; }
        int dev = 0, cus = 0, per_cu = 0;
        if (hipGetDevice(&dev) != hipSuccess || hipDeviceGetAttribute(&cus, hipDeviceAttributeMultiprocessorCount, dev) != hipSuccess) { grid = -1; return; }
        if (hipFuncSetAttribute((const void*)mk_fwd, hipFuncAttributeMaxDynamicSharedMemorySize, LDS_BYTES) != hipSuccess) { fprintf(stderr, "kernel_launch: hipFuncSetAttribute failed\n"); grid = -1; return; }
        if (hipOccupancyMaxActiveBlocksPerMultiprocessor(&per_cu, (const void*)mk_fwd, NWAVES * 64, LDS_BYTES) != hipSuccess || per_cu < 1) { fprintf(stderr, "kernel_launch: occupancy query says %d\n", per_cu); }
        (void)hipGetLastError();
        grid = cus;
        if (grid % 8 != 0) { fprintf(stderr, "kernel_launch: %d CUs: the per-workgroup row-scale tables assume a grid that is a multiple of 8\n", grid); grid = -1; return; }
    }
    if (grid < 0) return;
    (void)hipMemsetAsync((char*)d_ws + WS_CTL, 0, CTL_ZERO_BYTES, stream);
    Args a{};
    for (int i = 0; i < 19; ++i) a.in[i] = (const float*)d_in[i];
    a.out = (float*)d_out; a.ws = (unsigned char*)d_ws;
#if defined(DEBUG_GOLD)
    debug_forward(a, grid, stream);
#else
    if (N_LAUNCHES == 1) { a.ph_lo = 0; a.ph_hi = NPH; hipLaunchKernelGGL(mk_fwd, dim3(grid), dim3(NWAVES * 64), LDS_BYTES, stream, a); }
    else for (int p = 0; p < NPH; ++p) { a.ph_lo = p; a.ph_hi = p + 1; hipLaunchKernelGGL(mk_fwd, dim3(grid), dim3(NWAVES * 64), LDS_BYTES, stream, a); }
#endif
}
```
